# Optimizing an MI355X kernel written in HIP

```python
import math
import jax, jax.numpy as jnp
from jax import lax
import numpy as np

D_MODEL = 1024
BATCH = 8
SEQ = 2048
DEPTH = 1
DEC_BATCH = 128
DEC_SEQ = 4
PAST_LEN = 16384
PAGE_SIZE = 128

W_MIX = D_MODEL
W_SSM = W_MIX // 2
W_CONV = W_MIX - W_SSM
GROUP_P = 16
N_GROUPS = W_SSM // GROUP_P
N_STATE = 64
CONV_K = 31
IN_COLS = 2 * W_SSM + 3 * W_CONV
ALPHA = (2.0 * DEPTH) ** 0.25
BETA = (8.0 * DEPTH) ** -0.25
LN_EPS = 1e-5
DT_MIN = 0.001
DT_MAX = 0.1

kernel_name = "hymba_s5_conformer_conv_deepnorm_step"


def _layernorm(x, g, b):
    xf = x.astype(jnp.float32)
    mu = jnp.mean(xf, axis=-1, keepdims=True)
    var = jnp.mean(jnp.square(xf - mu), axis=-1, keepdims=True)
    y = (xf - mu) * lax.rsqrt(var + LN_EPS) * g.astype(jnp.float32) + b.astype(jnp.float32)
    return y.astype(x.dtype)


def _scan_combine(e1, e2):
    a1, b1 = e1
    a2, b2 = e2
    return a1 * a2, a2 * b1 + b2


def _s5(u, h0, lam_re, lam_im, log_dt, b_re, b_im, c_re, c_im, d_skip):
    bsz, length, _ = u.shape
    f32 = jnp.float32
    uf = u.astype(f32).reshape(bsz, length, N_GROUPS, GROUP_P)
    lam = lax.complex(lam_re.astype(f32), lam_im.astype(f32))
    dt = jnp.exp(log_dt.astype(f32))[:, None]
    lam_bar = jnp.exp(lam * dt)
    bmat = lax.complex(b_re.astype(f32), b_im.astype(f32))
    b_bar = ((lam_bar - 1.0) / lam)[..., None] * bmat
    bu = jnp.einsum('blgp,gnp->blgn', uf.astype(jnp.complex64), b_bar)
    bu = bu.at[:, 0].add(lam_bar[None] * h0)
    a = jnp.broadcast_to(lam_bar, bu.shape)
    _, h = lax.associative_scan(_scan_combine, (a, bu), axis=1)
    cmat = lax.complex(c_re.astype(f32), c_im.astype(f32))
    y = jnp.real(jnp.einsum('blgn,gpn->blgp', h, cmat)) + uf * d_skip.astype(f32).reshape(N_GROUPS, GROUP_P)
    return y.reshape(bsz, length, W_SSM), h[:, -1]


def _conformer_conv(a, b, buf, w_dw, b_dw, g_ln, b_ln, w_pw2, b_pw2):
    v = a * jax.nn.sigmoid(b)
    full = jnp.concatenate([buf.astype(v.dtype), v], axis=1)
    new_buf = full[:, -(CONV_K - 1):]
    out = lax.conv_general_dilated(
        full, w_dw.astype(full.dtype)[:, None, :], window_strides=(1,), padding='VALID',
        dimension_numbers=('NWC', 'WIO', 'NWC'), feature_group_count=W_CONV) + b_dw
    out = _layernorm(out, g_ln, b_ln)
    out = jax.nn.silu(out)
    out = out @ w_pw2 + b_pw2
    return out, new_buf


def _layer(x, h0, conv_buf, w_in, b_in, lam_re, lam_im, log_dt, b_re, b_im, c_re, c_im,
           d_skip, w_glu, b_glu, w_dw, b_dw, g_conv_ln, b_conv_ln, w_pw2, b_pw2,
           w_out, g_post, b_post):
    z = x @ w_in + b_in
    u_s, g_s, a_c, b_c, g_c = jnp.split(
        z, [W_SSM, 2 * W_SSM, 2 * W_SSM + W_CONV, 2 * W_SSM + 2 * W_CONV], axis=-1)
    y_s, h_last = _s5(u_s, h0, lam_re, lam_im, log_dt, b_re, b_im, c_re, c_im, d_skip)
    s = jax.nn.gelu(y_s).astype(x.dtype)
    s = s * jax.nn.sigmoid(s @ w_glu + b_glu)
    s = s * jax.nn.silu(g_s)
    c, new_buf = _conformer_conv(a_c, b_c, conv_buf, w_dw, b_dw, g_conv_ln, b_conv_ln, w_pw2, b_pw2)
    c = c * jax.nn.silu(g_c)
    mix = jnp.concatenate([s, c.astype(x.dtype)], axis=-1) @ w_out
    y = _layernorm(ALPHA * x + mix, g_post, b_post)
    return y, h_last, new_buf


def setup_inputs(seed: int = 0) -> dict:
    key = jax.random.key(seed)
    ks = jax.random.split(key, 32)
    f32 = jnp.float32
    nrm = lambda k, shape, s: (jax.random.normal(k, shape, f32) * s)
    n_idx = jnp.arange(N_STATE, dtype=f32)
    lam_re = -0.5 * jnp.ones((DEPTH, N_GROUPS, N_STATE), f32) + nrm(ks[5], (DEPTH, N_GROUPS, N_STATE), 0.01)
    lam_im = jnp.pi * n_idx[None, None, :] + nrm(ks[6], (DEPTH, N_GROUPS, N_STATE), 0.01)
    log_dt = jax.random.uniform(ks[7], (DEPTH, N_GROUPS), f32, math.log(DT_MIN), math.log(DT_MAX))
    bscale = (2.0 * GROUP_P) ** -0.5
    cscale = (2.0 * N_STATE) ** -0.5
    return {
        "x_prompt": nrm(ks[0], (BATCH, SEQ, D_MODEL), 1.0),
        "x_sample": nrm(ks[1], (DEC_BATCH, DEC_SEQ, D_MODEL), 1.0),
        "state_ssm_re": nrm(ks[2], (DEPTH, DEC_BATCH, N_GROUPS, N_STATE), 0.5),
        "state_ssm_im": nrm(ks[3], (DEPTH, DEC_BATCH, N_GROUPS, N_STATE), 0.5),
        "state_conv": nrm(ks[4], (DEPTH, DEC_BATCH, CONV_K - 1, W_CONV), 1.0),
        "w_in": nrm(ks[8], (DEPTH, D_MODEL, IN_COLS), D_MODEL ** -0.5),
        "b_in": nrm(ks[9], (DEPTH, IN_COLS), 0.01),
        "lam_re": lam_re,
        "lam_im": lam_im,
        "log_dt": log_dt,
        "b_re": nrm(ks[10], (DEPTH, N_GROUPS, N_STATE, GROUP_P), bscale),
        "b_im": nrm(ks[11], (DEPTH, N_GROUPS, N_STATE, GROUP_P), bscale),
        "c_re": nrm(ks[12], (DEPTH, N_GROUPS, GROUP_P, N_STATE), cscale),
        "c_im": nrm(ks[13], (DEPTH, N_GROUPS, GROUP_P, N_STATE), cscale),
        "d_skip": nrm(ks[14], (DEPTH, W_SSM), 1.0),
        "w_glu": nrm(ks[15], (DEPTH, W_SSM, W_SSM), W_SSM ** -0.5),
        "b_glu": nrm(ks[16], (DEPTH, W_SSM), 0.01),
        "w_dw": nrm(ks[17], (DEPTH, CONV_K, W_CONV), CONV_K ** -0.5),
        "b_dw": nrm(ks[18], (DEPTH, W_CONV), 0.01),
        "g_conv_ln": 1.0 + nrm(ks[19], (DEPTH, W_CONV), 0.02),
        "b_conv_ln": nrm(ks[20], (DEPTH, W_CONV), 0.01),
        "w_pw2": nrm(ks[21], (DEPTH, W_CONV, W_CONV), W_CONV ** -0.5),
        "b_pw2": nrm(ks[22], (DEPTH, W_CONV), 0.01),
        "w_out": nrm(ks[23], (DEPTH, W_MIX, D_MODEL), BETA * W_MIX ** -0.5),
        "g_post": 1.0 + nrm(ks[24], (DEPTH, D_MODEL), 0.02),
        "b_post": nrm(ks[25], (DEPTH, D_MODEL), 0.01),
    }


def reference(x_prompt, x_sample, state_ssm_re, state_ssm_im, state_conv, w_in, b_in,
              lam_re, lam_im, log_dt, b_re, b_im, c_re, c_im, d_skip, w_glu, b_glu,
              w_dw, b_dw, g_conv_ln, b_conv_ln, w_pw2, b_pw2, w_out, g_post, b_post):
    f32 = jnp.float32
    hp = x_prompt
    hs = x_sample
    re_p, im_p, cv_p, re_s, im_s, cv_s = [], [], [], [], [], []
    for layer in range(DEPTH):
        params = (w_in[layer], b_in[layer], lam_re[layer], lam_im[layer], log_dt[layer],
                  b_re[layer], b_im[layer], c_re[layer], c_im[layer], d_skip[layer],
                  w_glu[layer], b_glu[layer], w_dw[layer], b_dw[layer], g_conv_ln[layer],
                  b_conv_ln[layer], w_pw2[layer], b_pw2[layer], w_out[layer],
                  g_post[layer], b_post[layer])
        h0_p = jnp.zeros((hp.shape[0], N_GROUPS, N_STATE), jnp.complex64)
        buf_p = jnp.zeros((hp.shape[0], CONV_K - 1, W_CONV), hp.dtype)
        hp, hl_p, nb_p = _layer(hp, h0_p, buf_p, *params)
        h0_s = lax.complex(state_ssm_re[layer].astype(f32), state_ssm_im[layer].astype(f32))
        hs, hl_s, nb_s = _layer(hs, h0_s, state_conv[layer], *params)
        re_p.append(jnp.real(hl_p)); im_p.append(jnp.imag(hl_p)); cv_p.append(nb_p)
        re_s.append(jnp.real(hl_s)); im_s.append(jnp.imag(hl_s)); cv_s.append(nb_s)
    return (hp, hs,
            jnp.stack(re_p), jnp.stack(im_p), jnp.stack(cv_p),
            jnp.stack(re_s), jnp.stack(im_s), jnp.stack(cv_s))
```

```cpp
#include <hip/hip_runtime.h>
#include <cstdio>
#include <cstdint>
namespace pg8 {
#define PG8_LAS __attribute__((address_space(3)))
typedef unsigned short bf16_t;
typedef short bf16x8 __attribute__((ext_vector_type(8)));
typedef float f32x4 __attribute__((ext_vector_type(4)));
typedef unsigned u32x4 __attribute__((ext_vector_type(4)));
constexpr int BM = 256, BK = 64, HALF = 128, HTB = HALF * BK * 2  , STAGE_BYTES = 8 * HTB, NXCD = 8, WGM = 8;

__host__ __device__ __forceinline__ int lds_byte(int r, int c) { const int st = (r >> 4) * 2 + (c >> 5), rr = r & 15, cc = c & 31, ob = rr * 64 + cc * 2; return st * 1024 + (ob ^ (((ob >> 9) & 1) << 5)); }
__host__ __device__ __forceinline__ void stage_rc(int b, int& R, int& C) { const int st = b / 1024, sb = b % 1024, swz = sb ^ (((sb >> 9) & 1) << 5); R = (st >> 1) * 16 + swz / 64; C = (st & 1) * 32 + (swz % 64) / 2; }
__host__ __device__ __forceinline__ int perm32(int rho) { const int n = rho >> 4, i = rho & 15; return 8 * (i >> 2) + 4 * n + (i & 3); }

struct Unit { int pm, pn; };
struct Gemm { const bf16_t* A; const bf16_t* Bt; int M, N, K; };

struct StaticOrder {
    int nM, nN, nwg, G, c;
    __host__ __device__ void init(int M, int N, int G_, int c_) { nM = M / BM; nN = N / BM; nwg = nM * nN; G = G_; c = c_; }
    __host__ __device__ bool next(int i, Unit& u) const {
        const long L = (long)i * G + c; if (L >= nwg) return false;
        int wgid = (int)L; { const int q = nwg / NXCD, r = nwg % NXCD, xcd = wgid % NXCD, off = wgid / NXCD; wgid = (xcd < r ? xcd * (q + 1) : r * (q + 1) + (xcd - r) * q) + off; }
        const int nig = WGM * nN, gid = wgid / nig, fm = gid * WGM, gsz = (nM - fm) < WGM ? (nM - fm) : WGM;
        u.pm = fm + ((wgid % nig) % gsz); u.pn = (wgid % nig) / gsz; return true;
    }
    __device__ __forceinline__ void a_ready(const Unit&) const {}
    __device__ __forceinline__ void done(const Unit&) const {}
};
__device__ __forceinline__ unsigned cvt_pk_bf16(float lo, float hi) { unsigned r; asm volatile("v_cvt_pk_bf16_f32 %0, %1, %2" : "=v"(r) : "v"(lo), "v"(hi)); return r; }
template <class Epi, class Sched, bool ALIGN_EPI = false, bool SP2 = false>
__device__ __forceinline__ void gemm_phase(PG8_LAS unsigned char* lds, const Gemm g, const Sched& S, const Epi& E) {
    int tid_ = threadIdx.x; asm volatile("" : "+v"(tid_));
    const int tid = tid_, wid = __builtin_amdgcn_readfirstlane(tid >> 6), lane = tid & 63, wr = wid >> 2, wc = wid & 3, fr = lane & 15, fq = lane >> 4;
    const int K = g.K, nt = K / BK;
    unsigned voffA[2], voffB[2];
#pragma unroll
    for (int i = 0; i < 2; ++i) { int R, C; stage_rc(tid * 16 + i * 8192, R, C); const int Rb = Epi::PERM ? ((R & ~31) + perm32(R & 31)) : R;
        voffA[i] = (unsigned)(R * K + C) * 2u; voffB[i] = (unsigned)(Rb * K + C) * 2u; }
    const size_t kstep = (size_t)(BK * 2);
    const size_t hstep = (size_t)HALF * K * 2;
    const size_t tstep = 2 * hstep;
    const unsigned ldsw = (unsigned)wid * 1024u;
    const int aoff = lds_byte(wr * 64 + fr, fq * 8), boff = lds_byte(wc * 32 + fr, fq * 8);
#define PG8_SA(b, h) (((b) * 2 + (h)) * HTB)
#define PG8_SB(b, h) ((4 + (b) * 2 + (h)) * HTB)
#define PG8_STAGE(bufoff, gbase, voff) do { _Pragma("unroll") for (int _i = 0; _i < 2; ++_i) \
        __builtin_amdgcn_global_load_lds((const unsigned*)((const char*)(gbase) + (voff)[_i]), (PG8_LAS unsigned*)(lds + (bufoff) + ldsw + _i * 8192), 16, 0, 0); } while (0)
#define PG8_LDA(dst, b, h) do { _Pragma("unroll") for (int m = 0; m < 4; ++m) _Pragma("unroll") for (int k = 0; k < 2; ++k) dst[m][k] = *(const PG8_LAS bf16x8*)(lds + PG8_SA(b, h) + aoff + m * 2048 + k * 1024); } while (0)
#define PG8_LDB(dst, b, h) do { _Pragma("unroll") for (int n = 0; n < 2; ++n) _Pragma("unroll") for (int k = 0; k < 2; ++k) dst[n][k] = *(const PG8_LAS bf16x8*)(lds + PG8_SB(b, h) + boff + n * 2048 + k * 1024); } while (0)
#define PG8_MMA(ai, bj, At, Bt) do { __builtin_amdgcn_s_setprio(1); _Pragma("unroll") for (int m = 0; m < 4; ++m) _Pragma("unroll") for (int n = 0; n < 2; ++n) _Pragma("unroll") for (int k = 0; k < 2; ++k) \
        acc[ai][bj][m][n] = __builtin_amdgcn_mfma_f32_16x16x32_bf16(Bt[n][k], At[m][k], acc[ai][bj][m][n], 0, 0, 0); __builtin_amdgcn_s_setprio(0); } while (0)
#define PG8_WAIT_V(n) asm volatile("s_waitcnt vmcnt(" #n ")" ::: "memory")
#define PG8_WAIT_L(n) asm volatile("s_waitcnt lgkmcnt(" #n ")" ::: "memory")
#define PG8_BAR __builtin_amdgcn_s_barrier()
#define PG8_SCHED __builtin_amdgcn_sched_barrier(0)
    Unit cur, nxt; int ui = 0;
    if (!S.next(0, cur)) return;
    f32x4 acc[2][2][4][2];
#pragma unroll
    for (int a = 0; a < 2; ++a)
#pragma unroll
        for (int b = 0; b < 2; ++b)
#pragma unroll
            for (int m = 0; m < 4; ++m)
#pragma unroll
                for (int n = 0; n < 2; ++n) acc[a][b][m][n] = (f32x4){0.f, 0.f, 0.f, 0.f};
    bf16x8 At[4][2], B0[2][2], B1[2][2];
    const char* cA = (const char*)g.A + (size_t)cur.pm * tstep; const char* cB = (const char*)g.Bt + (size_t)cur.pn * tstep;
    S.a_ready(cur);
    if constexpr (SP2) {
        PG8_STAGE(PG8_SB(0, 0), cB, voffB); PG8_STAGE(PG8_SB(0, 1), cB + hstep, voffB); PG8_STAGE(PG8_SA(0, 0), cA, voffA); PG8_STAGE(PG8_SA(0, 1), cA + hstep, voffA);
        if (wr == 1) PG8_BAR;
        PG8_WAIT_V(2); PG8_BAR;
        PG8_STAGE(PG8_SB(1, 0), cB + kstep, voffB); PG8_STAGE(PG8_SA(1, 0), cA + kstep, voffA); PG8_STAGE(PG8_SB(1, 1), cB + hstep + kstep, voffB);
        PG8_WAIT_V(6); PG8_BAR;
    } else {
        PG8_STAGE(PG8_SB(0, 0), cB, voffB); PG8_STAGE(PG8_SA(0, 0), cA, voffA); PG8_STAGE(PG8_SB(0, 1), cB + hstep, voffB); PG8_STAGE(PG8_SA(0, 1), cA + hstep, voffA);
        if (wr == 1) PG8_BAR;
        PG8_WAIT_V(4); PG8_BAR;
        PG8_STAGE(PG8_SB(1, 0), cB + kstep, voffB); PG8_STAGE(PG8_SA(1, 0), cA + kstep, voffA); PG8_STAGE(PG8_SB(1, 1), cB + hstep + kstep, voffB);
        PG8_WAIT_V(6); PG8_BAR;
    }
    for (;;) {
        const bool has_next = S.next(ui + 1, nxt);
        const char* nA = has_next ? (const char*)g.A + (size_t)nxt.pm * tstep : cA; const char* nB = has_next ? (const char*)g.Bt + (size_t)nxt.pn * tstep : cB;
        for (int t = 0; t < nt; t += 2) {
            const bool last = (t == nt - 2);
            const char* a1 = cA + (size_t)(t + 1) * kstep;
            const char* a2 = last ? nA : cA + (size_t)(t + 2) * kstep; const char* b2 = last ? nB : cB + (size_t)(t + 2) * kstep;
            const char* a3 = a2 + kstep; const char* b3 = b2 + kstep;
            if (last && has_next) S.a_ready(nxt);
            if constexpr (SP2) {
            PG8_LDB(B0, 0, 0); PG8_LDB(B1, 0, 1); PG8_SCHED; PG8_LDA(At, 0, 0); PG8_STAGE(PG8_SA(1, 1), a1 + hstep, voffA);
            PG8_WAIT_V(8); PG8_WAIT_L(0); PG8_BAR; PG8_MMA(0, 0, At, B0); PG8_MMA(0, 1, At, B1); PG8_BAR; PG8_SCHED;
            PG8_LDA(At, 0, 1); PG8_STAGE(PG8_SB(0, 0), b2, voffB); PG8_STAGE(PG8_SB(0, 1), b2 + hstep, voffB); PG8_STAGE(PG8_SA(0, 0), a2, voffA);
            PG8_WAIT_V(8); PG8_WAIT_L(0); PG8_BAR; PG8_MMA(1, 0, At, B0); PG8_MMA(1, 1, At, B1); PG8_BAR; PG8_SCHED;
            PG8_LDB(B0, 1, 0); PG8_LDB(B1, 1, 1); PG8_SCHED; PG8_LDA(At, 1, 0); PG8_STAGE(PG8_SA(0, 1), a2 + hstep, voffA);
            PG8_WAIT_V(8); PG8_WAIT_L(0); PG8_BAR; PG8_MMA(0, 0, At, B0); PG8_MMA(0, 1, At, B1); PG8_BAR; PG8_SCHED;
            PG8_LDA(At, 1, 1); PG8_STAGE(PG8_SB(1, 0), b3, voffB); PG8_STAGE(PG8_SB(1, 1), b3 + hstep, voffB); PG8_STAGE(PG8_SA(1, 0), a3, voffA);
            PG8_WAIT_V(8); PG8_WAIT_L(0); PG8_BAR; PG8_MMA(1, 0, At, B0); PG8_MMA(1, 1, At, B1); PG8_BAR; PG8_SCHED;
            } else {
            PG8_LDB(B0, 0, 0); PG8_SCHED; PG8_LDA(At, 0, 0); PG8_STAGE(PG8_SA(1, 1), a1 + hstep, voffA);
            PG8_WAIT_L(8); PG8_BAR; PG8_WAIT_L(0); PG8_MMA(0, 0, At, B0); PG8_BAR; PG8_SCHED;
            PG8_LDB(B1, 0, 1); PG8_STAGE(PG8_SB(0, 0), b2, voffB);
            PG8_BAR; PG8_WAIT_L(0); PG8_MMA(0, 1, At, B1); PG8_BAR;
            PG8_LDA(At, 0, 1); PG8_STAGE(PG8_SA(0, 0), a2, voffA);
            PG8_BAR; PG8_WAIT_L(0); PG8_MMA(1, 0, At, B0); PG8_BAR; PG8_SCHED;
            PG8_STAGE(PG8_SB(0, 1), b2 + hstep, voffB);
            PG8_WAIT_V(6); PG8_BAR; PG8_MMA(1, 1, At, B1); PG8_BAR;
            PG8_LDB(B0, 1, 0); PG8_SCHED; PG8_LDA(At, 1, 0); PG8_STAGE(PG8_SA(0, 1), a2 + hstep, voffA);
            PG8_WAIT_L(8); PG8_BAR; PG8_WAIT_L(0); PG8_MMA(0, 0, At, B0); PG8_BAR; PG8_SCHED;
            PG8_LDB(B1, 1, 1); PG8_STAGE(PG8_SB(1, 0), b3, voffB);
            PG8_BAR; PG8_WAIT_L(0); PG8_MMA(0, 1, At, B1); PG8_BAR;
            PG8_LDA(At, 1, 1); PG8_STAGE(PG8_SA(1, 0), a3, voffA);
            PG8_BAR; PG8_WAIT_L(0); PG8_MMA(1, 0, At, B0); PG8_BAR; PG8_SCHED;
            PG8_STAGE(PG8_SB(1, 1), b3 + hstep, voffB);
            PG8_WAIT_V(6); PG8_BAR; PG8_MMA(1, 1, At, B1); PG8_BAR;
            }
        }
        if constexpr (ALIGN_EPI) { if (wr == 0) PG8_BAR; }
        if constexpr (!Epi::AFTER_DRAIN) { E(acc, cur, wr, wc, fr, fq); S.done(cur); }
        if (!has_next) break;
#pragma unroll
        for (int a = 0; a < 2; ++a)
#pragma unroll
            for (int b = 0; b < 2; ++b)
#pragma unroll
                for (int m = 0; m < 4; ++m)
#pragma unroll
                    for (int n = 0; n < 2; ++n) acc[a][b][m][n] = (f32x4){0.f, 0.f, 0.f, 0.f};
        cur = nxt; cA = nA; cB = nB; ++ui;
        if constexpr (ALIGN_EPI) { if (wr == 1) PG8_BAR; }
    }
    PG8_WAIT_V(0);
    if constexpr (!ALIGN_EPI) { if (wr == 0) PG8_BAR; }
    PG8_BAR;
    if constexpr (Epi::AFTER_DRAIN) { E.fused(acc, cur, wr, wc, fr, fq, lds, wid, lane); S.done(cur); }
#undef PG8_SA
#undef PG8_SB
#undef PG8_STAGE
#undef PG8_LDA
#undef PG8_LDB
#undef PG8_MMA
#undef PG8_WAIT_V
#undef PG8_WAIT_L
#undef PG8_BAR
#undef PG8_SCHED
}
}
#define GAS __attribute__((address_space(1)))
#define LAS __attribute__((address_space(3)))
typedef unsigned short bf16;
typedef unsigned v4u __attribute__((ext_vector_type(4)));
typedef float f32x4 __attribute__((ext_vector_type(4)));
typedef short bf16x8 __attribute__((ext_vector_type(8)));
typedef GAS unsigned gu32;
typedef GAS unsigned long long gu64;
#define RLX_AGENT __ATOMIC_RELAXED, __HIP_MEMORY_SCOPE_AGENT
#define LDS_WAIT() asm volatile("s_waitcnt lgkmcnt(0)" ::: "memory")
#define VM_WAIT() asm volatile("s_waitcnt vmcnt(0)" ::: "memory")
__device__ __forceinline__ unsigned long long rt() { return __builtin_amdgcn_s_memrealtime(); }
__device__ __forceinline__ unsigned f2bf(float f) { unsigned u = __builtin_bit_cast(unsigned, f); return (u + 0x7fffu + ((u >> 16) & 1u)) >> 16; }
__device__ __forceinline__ unsigned pk2(float lo, float hi) { return f2bf(lo) | (f2bf(hi) << 16); }
#define XB_TMO      128
#define XB_XCNT(j)  (256  + 64 * (j))
#define XB_XSUB(j)  (1280 + 64 * (j))
#define XB_XGEN(j)  (2304 + 64 * (j))
#define XB_TOP      3328
#define XB_TOPGEN   3392
#define XCD_BAR_WORDS 3456
#define XB_SPIN_CAP (1u << 18)

__device__ __forceinline__ unsigned xb_ld(unsigned* p)              { return __hip_atomic_load(p, __ATOMIC_RELAXED, __HIP_MEMORY_SCOPE_AGENT); }
__device__ __forceinline__ unsigned xb_add(unsigned* p, unsigned v) { return __hip_atomic_fetch_add(p, v, __ATOMIC_RELAXED, __HIP_MEMORY_SCOPE_AGENT); }
__device__ __forceinline__ unsigned xb_xcc_id() { return (unsigned)__builtin_amdgcn_s_getreg((3 << 11) | 20) & 0xFu; }
#define XB_SPIN(cond, bar) do { unsigned _sp = 0; while (cond) { __builtin_amdgcn_s_sleep(1); \
    if ((++_sp & 255u) == 0u) { if (xb_ld(&(bar)[XB_TMO])) break; if (_sp > XB_SPIN_CAP) { atomicAdd(&(bar)[XB_TMO], 1u); break; } } } } while (0)

struct XcdBarrier {
    unsigned* bar; unsigned x;
    volatile LAS unsigned* st;
};

__device__ __forceinline__ XcdBarrier xcd_barrier_post(unsigned* bar, volatile LAS unsigned* st) {
    XcdBarrier b; b.bar = bar; b.x = xb_xcc_id(); b.st = st;
    if (threadIdx.x == 0) (void)xb_add(&bar[XB_XCNT(b.x)], 1u);
    return b;
}
__device__ __forceinline__ void xcd_barrier_complete(unsigned* bar, unsigned x, unsigned& nloc, unsigned& nx) {
    const unsigned G = gridDim.x * gridDim.y * gridDim.z;
    unsigned sum, cnt, mine, sp = 0u;
    for (;;) {
        sum = 0u; cnt = 0u; mine = 0u;
#pragma unroll
        for (unsigned j = 0; j < 16; ++j) { const unsigned c = xb_ld(&bar[XB_XCNT(j)]); sum += c; cnt += (c > 0u) ? 1u : 0u; mine = (j == x) ? c : mine; }
        if (sum == G) break;
        __builtin_amdgcn_s_sleep(1);
        if ((++sp & 255u) == 0u) { if (xb_ld(&bar[XB_TMO])) break; if (sp > XB_SPIN_CAP) { atomicAdd(&bar[XB_TMO], 1u); break; } }
    }
    nloc = mine > 0u ? mine : 1u; nx = cnt > 0u ? cnt : 1u;
}

__device__ __forceinline__ void xcd_barrier(const XcdBarrier& b) {
    asm volatile("s_waitcnt vmcnt(0)" ::: "memory");
    __syncthreads();
    if (threadIdx.x == 0) {
        unsigned* bar = b.bar;
        __builtin_amdgcn_s_waitcnt(0);
        unsigned nloc = b.st[0], nx = b.st[1];
        if (nloc == 0u) { xcd_barrier_complete(bar, b.x, nloc, nx); b.st[0] = nloc; b.st[1] = nx; }
        const unsigned old = xb_add(&bar[XB_XSUB(b.x)], 1u);
        const unsigned gen = old / nloc;
        if (old + 1u == (gen + 1u) * nloc) {
            __builtin_amdgcn_fence(__ATOMIC_RELEASE, "agent");
            asm volatile("s_waitcnt vmcnt(0)" ::: "memory");
            const unsigned og = xb_add(&bar[XB_TOP], 1u);
            const unsigned tg = og / nx;
            if (og + 1u == (tg + 1u) * nx) xb_add(&bar[XB_TOPGEN], 1u);
            else XB_SPIN(xb_ld(&bar[XB_TOPGEN]) == tg, bar);
            __builtin_amdgcn_fence(__ATOMIC_ACQUIRE, "agent");
            xb_add(&bar[XB_XGEN(b.x)], 1u);
            asm volatile("s_waitcnt vmcnt(0)" ::: "memory");
        } else {
            XB_SPIN(xb_ld(&bar[XB_XGEN(b.x)]) == gen, bar);
            __builtin_amdgcn_fence(__ATOMIC_ACQUIRE, "agent");
            asm volatile("s_waitcnt vmcnt(0)" ::: "memory");
        }
    }
    __syncthreads();
}
constexpr int NWAVES = 8, NT = 512;
constexpr int DM = 1024, MP = 16384, MSMP = 512, MT = MP + MSMP;
constexpr int NIN = 2560;
constexpr float LN_EPS = 1e-5f, ALPHA = 1.189207115002721f;
constexpr size_t MiB = 1u << 20;
constexpr size_t WS_CTL = 0, CTL_ZERO_BYTES = 1 * MiB;
constexpr size_t WS_WIN = 2 * MiB;
constexpr size_t WS_W2 = 7 * MiB;
constexpr size_t WS_WOUT = 8 * MiB;
constexpr size_t WS_CONST = 10 * MiB;
constexpr size_t WS_XB = 12 * MiB;
constexpr size_t WS_U = 46 * MiB, WS_GS = 63 * MiB, WS_V = 80 * MiB, WS_GC = 97 * MiB;
constexpr size_t WS_S0 = 114 * MiB;
constexpr size_t WS_CN = WS_S0 + (size_t)MT * 512 * 2;
constexpr size_t WS_MIX = 148 * MiB;
constexpr size_t WS_E = 182 * MiB, WS_HS = 198 * MiB;
constexpr size_t WS_END = 214 * MiB;
constexpr size_t C_LAM1 = 0, C_LAM16 = 16384, C_LAM256 = 32768, C_BIAS = 49152, C_BFRAG = 65536, C_CFRAG = 65536 + 131072;
constexpr size_t O_Y = 0, O_RE_P = 17301504, O_IM_P = 17317888, O_CV_P = 17334272, O_RE_S = 17457152, O_IM_S = 17719296, O_CV_S = 17981440, O_END = 19947520;
constexpr int CW_TMO = 0, CW_BAR = 4096;
constexpr int RING_OFF = 0, RING_BYTES = 131072, LDSCTL_OFF = RING_BYTES, MISC_OFF = LDSCTL_OFF + 320, STATS_OFF = RING_BYTES + 1024, LDS_BYTES = 147456;
typedef float f32x16 __attribute__((ext_vector_type(16)));
typedef float f32x2 __attribute__((ext_vector_type(2)));
typedef short s16x4 __attribute__((ext_vector_type(4)));
typedef unsigned v2u __attribute__((ext_vector_type(2)));
typedef __bf16 bf16x2_t __attribute__((ext_vector_type(2)));
__device__ __forceinline__ unsigned pkbf(float a, float b) { f32x2 v = {a, b}; return __builtin_bit_cast(unsigned, __builtin_convertvector(v, bf16x2_t)); }
__device__ __forceinline__ float bflo(unsigned w) { return __builtin_bit_cast(float, w << 16); }
__device__ __forceinline__ float bfhi(unsigned w) { return __builtin_bit_cast(float, w & 0xffff0000u); }
__device__ __forceinline__ float bf1(bf16 v) { return __builtin_bit_cast(float, (unsigned)v << 16); }
__device__ __forceinline__ float sigm(float x) { return __builtin_amdgcn_rcpf(1.0f + __builtin_amdgcn_exp2f(-1.4426950408889634f * x)); }
__device__ __forceinline__ float siluf(float x) { return x * sigm(x); }
__device__ __forceinline__ float gelu_tanh(float x) { const float z = 0.7978845608028654f * (x + 0.044715f * x * x * x); return x * sigm(2.0f * z); }
__device__ __forceinline__ float wave_sum(float v) {
#pragma unroll
    for (int o = 1; o < 64; o <<= 1) v += __shfl_xor(v, o);
    return v;
}
#define MFMA32(a, b, c) __builtin_amdgcn_mfma_f32_32x32x16_bf16((a), (b), (c), 0, 0, 0)

struct Args { const float* in[26]; float* out; unsigned char* ws; };
struct Frame {
    LAS unsigned char* lds;
    volatile LAS unsigned* MISC;
    gu32* ctl;
    int tid, lane, wave, vcu, G;
    float* out;
    unsigned char* ws;
};

__device__ __forceinline__ int win_perm(int c) {
    if (c < 1024 || c >= 2048) return c;
    if (c < 1536) { const int q = (c - 1024) >> 7, i = (c - 1024) & 127; return 1024 + 256 * q + i; }
    const int q = (c - 1536) >> 7, i = (c - 1536) & 127; return 1024 + 256 * q + 128 + i;
}

__device__ __forceinline__ void p0_transpose_item(const float* W, int K, int N, bf16* WT, int k0, int n0, int dst_row0, LAS float* scr, int lane) {
#pragma unroll 8
    for (int i = 0; i < 32; ++i) { const int kk = 2 * i + (lane >> 5); scr[kk * 33 + (lane & 31)] = W[(size_t)(k0 + kk) * N + n0 + (lane & 31)]; }
    LDS_WAIT(); asm volatile("" ::: "memory");
    const int c = lane & 7;
#pragma unroll
    for (int j = 0; j < 4; ++j) { const int n = (lane >> 3) + 8 * j; const LAS float* s = scr + (8 * c) * 33 + n;
        v4u o; o.x = pkbf(s[0 * 33], s[1 * 33]); o.y = pkbf(s[2 * 33], s[3 * 33]); o.z = pkbf(s[4 * 33], s[5 * 33]); o.w = pkbf(s[6 * 33], s[7 * 33]);
        *(v4u*)(WT + (size_t)(dst_row0 + n) * K + k0 + 8 * c) = o; }
    LDS_WAIT(); asm volatile("" ::: "memory");
}
__device__ __forceinline__ void s5_coef(const float* lam_re, const float* lam_im, const float* log_dt, int g, int n, double& lbr, double& lbi, double& cr, double& ci) {
    const double dt = exp((double)log_dt[g]);
    const double lr = (double)lam_re[g * 64 + n], li = (double)lam_im[g * 64 + n];
    const double mag = exp(lr * dt), ang = li * dt;
    lbr = mag * cos(ang); lbi = mag * sin(ang);
    const double ar = lbr - 1.0, ai = lbi, den = lr * lr + li * li;
    cr = (ar * lr + ai * li) / den; ci = (ai * lr - ar * li) / den;
}
__device__ __forceinline__ void p0_prologue(Frame& F, const Args& A) {
    LAS float* scr = (LAS float*)(F.lds + RING_OFF + F.wave * 16384);
    const int gw = F.vcu * NWAVES + F.wave, NGW = F.G * NWAVES;
    bf16* WinT = (bf16*)(F.ws + WS_WIN); bf16* W2T = (bf16*)(F.ws + WS_W2); bf16* WoutT = (bf16*)(F.ws + WS_WOUT);
    for (int it = gw; it < 2048; it += NGW) {
        int r = it;
        if (r < 1280) { const int kb = r / 80, nb = r % 80; p0_transpose_item(A.in[5], 1024, NIN, WinT, 64 * kb, 32 * nb, win_perm(32 * nb), scr, F.lane); continue; } r -= 1280;
        if (r < 128) { const int kb = r / 16, nb = r % 16; p0_transpose_item(A.in[15], 512, 512, W2T, 64 * kb, 32 * nb, 32 * nb, scr, F.lane); continue; } r -= 128;
        if (r < 128) { const int kb = r / 16, nb = r % 16; p0_transpose_item(A.in[21], 512, 512, W2T, 64 * kb, 32 * nb, 512 + 32 * nb, scr, F.lane); continue; } r -= 128;
        { const int kb = r / 32, nb = r % 32; p0_transpose_item(A.in[23], 1024, 1024, WoutT, 64 * kb, 32 * nb, 32 * nb, scr, F.lane); }
    }
    bf16* XB = (bf16*)(F.ws + WS_XB);
    for (int m = gw; m < MT; m += NGW) {
        const float* xrow = m < MP ? A.in[0] + (size_t)m * DM : A.in[1] + (size_t)(m - MP) * DM;
        const f32x4* xr = (const f32x4*)xrow + F.lane; v2u* o8 = (v2u*)(XB + (size_t)m * DM) + F.lane;
#pragma unroll
        for (int j = 0; j < 4; ++j) { const f32x4 v = xr[64 * j]; v2u o; o.x = pkbf(v.x, v.y); o.y = pkbf(v.z, v.w); o8[64 * j] = o; }
    }
    const int gt = F.vcu * NT + F.tid, GT = F.G * NT;
    unsigned char* cb = F.ws + WS_CONST;
    const float *lam_re = A.in[7], *lam_im = A.in[8], *log_dt = A.in[9], *b_re = A.in[10], *b_im = A.in[11], *c_re = A.in[12], *c_im = A.in[13];
    for (int idx = gt; idx < 2048; idx += GT) {
        const int g = idx >> 6, n = idx & 63; double lr, li, cr, ci; s5_coef(lam_re, lam_im, log_dt, g, n, lr, li, cr, ci);
        ((f32x2*)(cb + C_LAM1))[idx] = (f32x2){(float)lr, (float)li};
        double pr = lr, pi = li;
#pragma unroll 1
        for (int k = 0; k < 4; ++k) { const double t = pr * pr - pi * pi; pi = 2.0 * pr * pi; pr = t; }
        ((f32x2*)(cb + C_LAM16))[idx] = (f32x2){(float)pr, (float)pi};
#pragma unroll 1
        for (int k = 0; k < 4; ++k) { const double t = pr * pr - pi * pi; pi = 2.0 * pr * pi; pr = t; }
        ((f32x2*)(cb + C_LAM256))[idx] = (f32x2){(float)pr, (float)pi};
    }
    for (int idx = gt; idx < 8192; idx += GT) {
        const int lane = idx & 63, ct = (idx >> 6) & 3, g = idx >> 8, r = lane & 31, h = lane >> 5, st = 32 * (ct >> 1) + r;
        double lr, li, cr, ci; s5_coef(lam_re, lam_im, log_dt, g, st, lr, li, cr, ci);
        float v[8];
#pragma unroll
        for (int j = 0; j < 8; ++j) { const int p = 8 * h + j; const double br = (double)b_re[(g * 64 + st) * 16 + p], bi = (double)b_im[(g * 64 + st) * 16 + p];
            v[j] = (ct & 1) ? (float)(cr * bi + ci * br) : (float)(cr * br - ci * bi); }
        v4u o; o.x = pkbf(v[0], v[1]); o.y = pkbf(v[2], v[3]); o.z = pkbf(v[4], v[5]); o.w = pkbf(v[6], v[7]);
        ((v4u*)(cb + C_BFRAG))[idx] = o;
    }
    for (int idx = gt; idx < 16384; idx += GT) {
        const int lane = idx & 63, s = (idx >> 6) & 1, ct = (idx >> 7) & 3, g = idx >> 9, r = lane & 31, h = lane >> 5;
        float v[8];
#pragma unroll
        for (int j = 0; j < 8; ++j) { const int st = 32 * (ct >> 1) + 16 * s + 8 * h + j;
            v[j] = r < 16 ? ((ct & 1) ? -c_im[(g * 16 + r) * 64 + st] : c_re[(g * 16 + r) * 64 + st]) : 0.f; }
        v4u o; o.x = pkbf(v[0], v[1]); o.y = pkbf(v[2], v[3]); o.z = pkbf(v[4], v[5]); o.w = pkbf(v[6], v[7]);
        ((v4u*)(cb + C_CFRAG))[idx] = o;
    }
    for (int idx = gt; idx < NIN; idx += GT) ((float*)(cb + C_BIAS))[win_perm(idx)] = A.in[6][idx];
    { const f32x4* src = (const f32x4*)A.in[4]; f32x4* dst = (f32x4*)(F.out + O_CV_S);
      for (int idx = gt; idx < 128 * 3328; idx += GT) { const int s = idx / 3328, v = idx % 3328; dst[s * 3840 + v] = src[s * 3840 + 512 + v]; } }
}
struct EpiIn {
    static constexpr bool PERM = true, AFTER_DRAIN = false;
    bf16 *U, *GS, *V, *GC; const float* biasp; float *convp, *convs;
    __device__ __forceinline__ void operator()(const f32x4 (&acc)[2][2][4][2], const pg8::Unit& u, int wr, int wc, int fr, int fq) const {
        const int row0 = u.pm * 256 + wr * 64 + fr, pn = u.pn, cl = wc * 32 + 8 * fq;
        if (pn >= 4 && pn < 8) {
            const int q = pn - 4;
            const f32x4 ba0 = *(const f32x4*)(biasp + 1024 + 256 * q + cl), ba1 = *(const f32x4*)(biasp + 1024 + 256 * q + cl + 4);
            const f32x4 bb0 = *(const f32x4*)(biasp + 1024 + 256 * q + 128 + cl), bb1 = *(const f32x4*)(biasp + 1024 + 256 * q + 128 + cl + 4);
#pragma unroll
            for (int ai = 0; ai < 2; ++ai)
#pragma unroll
                for (int m = 0; m < 4; ++m) {
                    const int row = row0 + ai * 128 + m * 16;
                    const f32x4 a0 = acc[ai][0][m][0] + ba0, a1 = acc[ai][0][m][1] + ba1, b0 = acc[ai][1][m][0] + bb0, b1 = acc[ai][1][m][1] + bb1;
                    f32x4 v0, v1;
#pragma unroll
                    for (int e = 0; e < 4; ++e) { v0[e] = a0[e] * sigm(b0[e]); v1[e] = a1[e] * sigm(b1[e]); }
                    v4u w; w.x = pkbf(v0[0], v0[1]); w.y = pkbf(v0[2], v0[3]); w.z = pkbf(v1[0], v1[1]); w.w = pkbf(v1[2], v1[3]);
                    *(v4u*)(V + (size_t)row * 512 + 128 * q + cl) = w;
                    float* cd = nullptr;
                    if (row < MP) { const int t = row & 2047; if (t >= 2018) cd = convp + ((size_t)(row >> 11) * 30 + (t - 2018)) * 512 + 128 * q + cl; }
                    else { const int s = (row - MP) >> 2, j = row & 3; cd = convs + ((size_t)s * 30 + 26 + j) * 512 + 128 * q + cl; }
                    if (cd) { *(f32x4*)cd = v0; *(f32x4*)(cd + 4) = v1; }
                }
        } else {
            bf16* dst; int cofs; bool act;
            if (pn < 2) { dst = U; cofs = pn * 256; act = false; } else if (pn < 4) { dst = GS; cofs = (pn - 2) * 256; act = true; } else { dst = GC; cofs = (pn - 8) * 256; act = true; }
#pragma unroll
            for (int bj = 0; bj < 2; ++bj) {
                const f32x4 bv0 = *(const f32x4*)(biasp + pn * 256 + bj * 128 + cl), bv1 = *(const f32x4*)(biasp + pn * 256 + bj * 128 + cl + 4);
#pragma unroll
                for (int ai = 0; ai < 2; ++ai)
#pragma unroll
                    for (int m = 0; m < 4; ++m) {
                        const int row = row0 + ai * 128 + m * 16;
                        f32x4 v0 = acc[ai][bj][m][0] + bv0, v1 = acc[ai][bj][m][1] + bv1;
                        if (act) {
#pragma unroll
                            for (int e = 0; e < 4; ++e) { v0[e] = siluf(v0[e]); v1[e] = siluf(v1[e]); } }
                        v4u w; w.x = pkbf(v0[0], v0[1]); w.y = pkbf(v0[2], v0[3]); w.z = pkbf(v1[0], v1[1]); w.w = pkbf(v1[2], v1[3]);
                        *(v4u*)(dst + (size_t)row * 512 + cofs + bj * 128 + cl) = w;
                    }
            }
        }
    }
};
struct GroupedOrder {
    int G, c;
    __device__ __forceinline__ bool next(int i, pg8::Unit& u) const { const int L = i * G + c; if (L >= 264) return false; const int grp = L / 132, rem = L % 132; u.pm = grp * 66 + (rem >> 1); u.pn = grp * 2 + (rem & 1); return true; }
    __device__ __forceinline__ void a_ready(const pg8::Unit&) const {}
    __device__ __forceinline__ void done(const pg8::Unit&) const {}
};
struct EpiMix {
    static constexpr bool PERM = true, AFTER_DRAIN = false;
    const bf16 *S0, *GS, *GC; bf16* MIX; const float *b_glu, *b_pw2;
    __device__ __forceinline__ void operator()(const f32x4 (&acc)[2][2][4][2], const pg8::Unit& u, int wr, int wc, int fr, int fq) const {
        const int grp = u.pn >> 1, row0 = (u.pm - 66 * grp) * 256 + wr * 64 + fr, cl = wc * 32 + 8 * fq;
        const float* bias = grp ? b_pw2 : b_glu;
#pragma unroll
        for (int bj = 0; bj < 2; ++bj) {
            const int col = (u.pn & 1) * 256 + bj * 128 + cl;
            const f32x4 bv0 = *(const f32x4*)(bias + col), bv1 = *(const f32x4*)(bias + col + 4);
#pragma unroll
            for (int ai = 0; ai < 2; ++ai)
#pragma unroll
                for (int m = 0; m < 4; ++m) {
                    const int row = row0 + ai * 128 + m * 16;
                    const f32x4 v0 = acc[ai][bj][m][0] + bv0, v1 = acc[ai][bj][m][1] + bv1;
                    float r[8];
                    if (grp == 0) {
                        const v4u s = *(const v4u*)(S0 + (size_t)row * 512 + col), g = *(const v4u*)(GS + (size_t)row * 512 + col);
                        r[0] = sigm(v0[0]) * bflo(s.x) * bflo(g.x); r[1] = sigm(v0[1]) * bfhi(s.x) * bfhi(g.x); r[2] = sigm(v0[2]) * bflo(s.y) * bflo(g.y); r[3] = sigm(v0[3]) * bfhi(s.y) * bfhi(g.y);
                        r[4] = sigm(v1[0]) * bflo(s.z) * bflo(g.z); r[5] = sigm(v1[1]) * bfhi(s.z) * bfhi(g.z); r[6] = sigm(v1[2]) * bflo(s.w) * bflo(g.w); r[7] = sigm(v1[3]) * bfhi(s.w) * bfhi(g.w);
                    } else {
                        const v4u g = *(const v4u*)(GC + (size_t)row * 512 + col);
                        r[0] = v0[0] * bflo(g.x); r[1] = v0[1] * bfhi(g.x); r[2] = v0[2] * bflo(g.y); r[3] = v0[3] * bfhi(g.y);
                        r[4] = v1[0] * bflo(g.z); r[5] = v1[1] * bfhi(g.z); r[6] = v1[2] * bflo(g.w); r[7] = v1[3] * bfhi(g.w);
                    }
                    v4u w; w.x = pkbf(r[0], r[1]); w.y = pkbf(r[2], r[3]); w.z = pkbf(r[4], r[5]); w.w = pkbf(r[6], r[7]);
                    *(v4u*)(MIX + (size_t)row * 1024 + grp * 512 + col) = w;
                }
        }
    }
};
struct EpiOut {
    static constexpr bool PERM = false, AFTER_DRAIN = false;
    const float *xp, *xs; float* Y;
    __device__ __forceinline__ void operator()(const f32x4 (&acc)[2][2][4][2], const pg8::Unit& u, int wr, int wc, int fr, int fq) const {
        const int row0 = u.pm * 256 + wr * 64 + fr, col0 = u.pn * 256 + wc * 32 + 4 * fq;
#pragma unroll
        for (int ai = 0; ai < 2; ++ai)
#pragma unroll
            for (int m = 0; m < 4; ++m) {
                const int row = row0 + ai * 128 + m * 16;
                const float* xr = row < MP ? xp + (size_t)row * DM : xs + (size_t)(row - MP) * DM;
#pragma unroll
                for (int bj = 0; bj < 2; ++bj)
#pragma unroll
                    for (int n = 0; n < 2; ++n) { const int col = col0 + bj * 128 + n * 16; const f32x4 xv = *(const f32x4*)(xr + col);
                        *(f32x4*)(Y + (size_t)row * DM + col) = xv * ALPHA + acc[ai][bj][m][n]; }
            }
    }
};
template <int MODE>
__device__ __forceinline__ void s5_unit(const Frame& F, int tile32, int g, LAS unsigned char* img, const float* ssm_re, const float* ssm_im, const float* d_skip) {
    const int lane = F.lane, r = lane & 31, h = lane >> 5;
    const bf16* U = (const bf16*)(F.ws + WS_U);
    const unsigned char* cb = F.ws + WS_CONST;
    const int rowbase = tile32 * 32;
    const int tokA = 16 * ((r >> 2) & 1) + (r & 3) + 4 * (r >> 3);
    const bf16x8 au = *(const bf16x8*)(U + (size_t)(rowbase + tokA) * 512 + 16 * g + 8 * h);
    f32x16 acc[4];
    const f32x16 zero16 = {0.f, 0.f, 0.f, 0.f, 0.f, 0.f, 0.f, 0.f, 0.f, 0.f, 0.f, 0.f, 0.f, 0.f, 0.f, 0.f};
#pragma unroll
    for (int ct = 0; ct < 4; ++ct) { const bf16x8 bfr = ((const bf16x8*)(cb + C_BFRAG))[(g * 4 + ct) * 64 + lane]; acc[ct] = MFMA32(au, bfr, zero16); }
#pragma unroll
    for (int sh = 0; sh < 2; ++sh) {
        const int n = 32 * sh + r;
        const f32x2 lam = ((const f32x2*)(cb + C_LAM1))[g * 64 + n];
        float hr = 0.f, hi = 0.f;
        if (MODE == 1) { const f32x2 hs = ((const f32x2*)(F.ws + WS_HS))[((size_t)(2 * tile32 + h) * 32 + g) * 64 + n]; hr = hs.x; hi = hs.y; }
#pragma unroll
        for (int i = 0; i < 16; ++i) {
            if (MODE == 2 && (i & 3) == 0) { const int seq = (tile32 - 512) * 8 + 4 * h + (i >> 2); hr = ssm_re[(seq * 32 + g) * 64 + n]; hi = ssm_im[(seq * 32 + g) * 64 + n]; }
            const float nr = lam.x * hr - lam.y * hi + acc[2 * sh][i], ni = lam.x * hi + lam.y * hr + acc[2 * sh + 1][i];
            hr = nr; hi = ni; acc[2 * sh][i] = hr; acc[2 * sh + 1][i] = hi;
            if (MODE == 2 && (i & 3) == 3) { const int seq = (tile32 - 512) * 8 + 4 * h + (i >> 2); F.out[O_RE_S + (seq * 32 + g) * 64 + n] = hr; F.out[O_IM_S + (seq * 32 + g) * 64 + n] = hi; }
        }
        if (MODE == 0) ((f32x2*)(F.ws + WS_E))[((size_t)(2 * tile32 + h) * 32 + g) * 64 + n] = (f32x2){hr, hi};
    }
    if (MODE == 0) return;
#pragma unroll
    for (int ct = 0; ct < 4; ++ct) {
        v4u w0, w1;
        w0.x = pkbf(acc[ct][0], acc[ct][1]); w0.y = pkbf(acc[ct][2], acc[ct][3]); w0.z = pkbf(acc[ct][4], acc[ct][5]); w0.w = pkbf(acc[ct][6], acc[ct][7]);
        w1.x = pkbf(acc[ct][8], acc[ct][9]); w1.y = pkbf(acc[ct][10], acc[ct][11]); w1.z = pkbf(acc[ct][12], acc[ct][13]); w1.w = pkbf(acc[ct][14], acc[ct][15]);
        LAS v4u* p = (LAS v4u*)(img + (ct * 32 + r) * 64 + 32 * h);
        p[0] = w0; p[1] = w1;
    }
    const int i16 = lane & 15, q = i16 >> 2, p4 = i16 & 3, blk = (lane >> 4) & 1;
    const unsigned taddr = (unsigned)(uintptr_t)img + (unsigned)((8 * h + q) * 64 + 8 * (4 * blk + p4));
    f32x16 y = zero16;
#pragma unroll
    for (int ct = 0; ct < 4; ++ct) {
        s16x4 lo0, hi0, lo1, hi1;
        asm volatile("s_waitcnt lgkmcnt(0)\n\tds_read_b64_tr_b16 %0, %4 offset:%5\n\tds_read_b64_tr_b16 %1, %4 offset:%6\n\tds_read_b64_tr_b16 %2, %4 offset:%7\n\tds_read_b64_tr_b16 %3, %4 offset:%8\n\ts_waitcnt lgkmcnt(0)"
                     : "=&v"(lo0), "=&v"(hi0), "=&v"(lo1), "=&v"(hi1) : "v"(taddr), "i"(ct * 2048), "i"(ct * 2048 + 256), "i"(ct * 2048 + 1024), "i"(ct * 2048 + 1280) : "memory");
        const bf16x8 h0 = __builtin_shufflevector(lo0, hi0, 0, 1, 2, 3, 4, 5, 6, 7), h1 = __builtin_shufflevector(lo1, hi1, 0, 1, 2, 3, 4, 5, 6, 7);
        const bf16x8 c0 = ((const bf16x8*)(cb + C_CFRAG))[((g * 4 + ct) * 2 + 0) * 64 + lane], c1 = ((const bf16x8*)(cb + C_CFRAG))[((g * 4 + ct) * 2 + 1) * 64 + lane];
        y = MFMA32(c0, h0, y); y = MFMA32(c1, h1, y);
    }
    const int row = rowbase + r;
    bf16* S0 = (bf16*)(F.ws + WS_S0);
#pragma unroll
    for (int hf = 0; hf < 2; ++hf) {
        const int p0 = 8 * hf + 4 * h, ch = 16 * g + p0;
        const v2u uu = *(const v2u*)(U + (size_t)row * 512 + ch);
        const f32x4 dk = *(const f32x4*)(d_skip + ch);
        const float y0 = gelu_tanh(y[4 * hf + 0] + dk[0] * bflo(uu.x)), y1 = gelu_tanh(y[4 * hf + 1] + dk[1] * bfhi(uu.x));
        const float y2 = gelu_tanh(y[4 * hf + 2] + dk[2] * bflo(uu.y)), y3 = gelu_tanh(y[4 * hf + 3] + dk[3] * bfhi(uu.y));
        v2u o; o.x = pkbf(y0, y1); o.y = pkbf(y2, y3);
        *(v2u*)(S0 + (size_t)row * 512 + ch) = o;
    }
}
template <int MODE>
__device__ __forceinline__ void s5_phase(const Frame& F, int tile_lo, int tile_hi, const float* ssm_re, const float* ssm_im, const float* d_skip) {
    LAS unsigned char* img = F.lds + RING_OFF + F.wave * 8192;
    const int gw = F.vcu * NWAVES + F.wave, NGW = F.G * NWAVES, nun = (tile_hi - tile_lo) * 32;
    for (int un = gw; un < nun; un += NGW) s5_unit<MODE>(F, tile_lo + (un >> 5), un & 31, img, ssm_re, ssm_im, d_skip);
}
__device__ __forceinline__ void s5_carry_phase(const Frame& F) {
    const unsigned char* cb = F.ws + WS_CONST;
    LAS f32x2* seg = (LAS f32x2*)(F.lds + RING_OFF);
    const int n = F.lane, w = F.wave;
    for (int un = F.vcu; un < 256; un += F.G) {
        const int b = un >> 5, g = un & 31;
        const f32x2 l16 = ((const f32x2*)(cb + C_LAM16))[g * 64 + n], l256 = ((const f32x2*)(cb + C_LAM256))[g * 64 + n];
        const f32x2* E = (const f32x2*)(F.ws + WS_E) + ((size_t)(b * 128 + 16 * w) * 32 + g) * 64 + n;
        f32x2* HS = (f32x2*)(F.ws + WS_HS) + ((size_t)(b * 128 + 16 * w) * 32 + g) * 64 + n;
        float pr[16], pi[16];
#pragma unroll
        for (int j = 0; j < 16; ++j) { const f32x2 e = E[(size_t)j * 2048]; pr[j] = e.x; pi[j] = e.y; }
#pragma unroll
        for (int j = 1; j < 16; ++j) { const float tr = l16.x * pr[j - 1] - l16.y * pi[j - 1] + pr[j], ti = l16.x * pi[j - 1] + l16.y * pr[j - 1] + pi[j]; pr[j] = tr; pi[j] = ti; }
        seg[w * 64 + n] = (f32x2){pr[15], pi[15]};
        __syncthreads();
        float cr = 0.f, ci = 0.f;
        for (int k = 0; k < w; ++k) { const f32x2 t = seg[k * 64 + n]; const float tr = l256.x * cr - l256.y * ci + t.x, ti = l256.x * ci + l256.y * cr + t.y; cr = tr; ci = ti; }
#pragma unroll
        for (int j = 0; j < 16; ++j) {
            f32x2 hs; hs.x = cr + (j ? pr[j - 1] : 0.f); hs.y = ci + (j ? pi[j - 1] : 0.f);
            HS[(size_t)j * 2048] = hs;
            const float tr = l16.x * cr - l16.y * ci, ti = l16.x * ci + l16.y * cr; cr = tr; ci = ti;
        }
        if (w == 7) { F.out[O_RE_P + (b * 32 + g) * 64 + n] = cr + pr[15]; F.out[O_IM_P + (b * 32 + g) * 64 + n] = ci + pi[15]; }
        __syncthreads();
    }
}
__device__ __forceinline__ void conv_ln_store(const Frame& F, LAS float* tile, LAS f32x2* stats, int ntok, int rowbase, int ch, float gl, float bl, bf16* CN) {
    __syncthreads();
    for (int t = F.wave; t < ntok; t += NWAVES) {
        const f32x4 a = *(const LAS f32x4*)(tile + t * 512 + 4 * F.lane), c = *(const LAS f32x4*)(tile + t * 512 + 256 + 4 * F.lane);
        const float mean = wave_sum((a.x + a.y) + (a.z + a.w) + (c.x + c.y) + (c.z + c.w)) * (1.0f / 512.0f);
        const f32x4 da = a - mean, dc = c - mean;
        const float var = wave_sum((da.x * da.x + da.y * da.y) + (da.z * da.z + da.w * da.w) + (dc.x * dc.x + dc.y * dc.y) + (dc.z * dc.z + dc.w * dc.w)) * (1.0f / 512.0f);
        if (F.lane == 0) stats[t] = (f32x2){mean, 1.0f / sqrtf(var + LN_EPS)};
    }
    __syncthreads();
#pragma unroll 4
    for (int t = 0; t < ntok; ++t) { const f32x2 st = stats[t]; const float yv = (tile[t * 512 + ch] - st.x) * st.y * gl + bl; CN[(size_t)(rowbase + t) * 512 + ch] = (bf16)(pkbf(siluf(yv), 0.f) & 0xffffu); }
    __syncthreads();
}
__device__ __forceinline__ void conv_phase(const Frame& F, const float* state_conv, const float* w_dw, const float* b_dw, const float* g_ln, const float* b_ln) {
    const int ch = F.tid;
    const bf16* V = (const bf16*)(F.ws + WS_V); bf16* CN = (bf16*)(F.ws + WS_CN);
    LAS float* tile = (LAS float*)(F.lds + RING_OFF);
    LAS f32x2* stats = (LAS f32x2*)(F.lds + STATS_OFF);
    float w[31];
#pragma unroll
    for (int k = 0; k < 31; ++k) w[k] = w_dw[k * 512 + ch];
    const float bdw = b_dw[ch], gl = g_ln[ch], bl = b_ln[ch];
    for (int ut = F.vcu; ut < 256; ut += F.G) {
        const int b = ut >> 5, t0 = (ut & 31) * 64, rowbase = b * 2048 + t0;
        const bool first = (t0 == 0);
        const bf16* Vu = V + (size_t)(rowbase - 30) * 512;
        float acc[31];
#pragma unroll
        for (int s = 0; s < 94; ++s) {
            float x = bf1(Vu[s * 512 + ch]);
            if (s < 30) x = first ? 0.f : x;
#pragma unroll
            for (int k = 0; k < 31; ++k) { const int j = s - k;
                if (j >= 0 && j < 64) { if (k == 0) acc[j % 31] = bdw + w[0] * x; else acc[j % 31] += w[k] * x; } }
            if (s >= 30) tile[(s - 30) * 512 + ch] = acc[(s - 30) % 31];
        }
        conv_ln_store(F, tile, stats, 64, rowbase, ch, gl, bl, CN);
    }
    for (int sq = F.vcu; sq < 128; sq += F.G) {
        float ve[34];
#pragma unroll
        for (int i = 0; i < 30; ++i) ve[i] = state_conv[((size_t)sq * 30 + i) * 512 + ch];
#pragma unroll
        for (int i = 0; i < 4; ++i) ve[30 + i] = bf1(V[(size_t)(MP + 4 * sq + i) * 512 + ch]);
#pragma unroll
        for (int j = 0; j < 4; ++j) { float a = bdw;
#pragma unroll
            for (int k = 0; k < 31; ++k) a += w[k] * ve[j + k];
            tile[j * 512 + ch] = a; }
        conv_ln_store(F, tile, stats, 4, MP + 4 * sq, ch, gl, bl, CN);
    }
}
__device__ __forceinline__ void ln_phase(const Frame& F, const float* g_post, const float* b_post) {
    const int gw = F.vcu * NWAVES + F.wave, NGW = F.G * NWAVES;
    for (int m = gw; m < MT; m += NGW) {
        f32x4* xr = (f32x4*)(F.out + O_Y + (size_t)m * DM) + F.lane;
        f32x4 v[4]; float s = 0.f;
#pragma unroll
        for (int j = 0; j < 4; ++j) { v[j] = xr[64 * j]; s += (v[j].x + v[j].y) + (v[j].z + v[j].w); }
        const float mean = wave_sum(s) * (1.f / DM); float s2 = 0.f;
#pragma unroll
        for (int j = 0; j < 4; ++j) { v[j] = v[j] - mean; s2 += (v[j].x * v[j].x + v[j].y * v[j].y) + (v[j].z * v[j].z + v[j].w * v[j].w); }
        const float rstd = 1.f / sqrtf(wave_sum(s2) * (1.f / DM) + LN_EPS);
#pragma unroll
        for (int j = 0; j < 4; ++j) { const f32x4 gp = ((const f32x4*)g_post)[64 * j + F.lane], bp = ((const f32x4*)b_post)[64 * j + F.lane]; xr[64 * j] = v[j] * rstd * gp + bp; }
    }
}
__global__ void __launch_bounds__(NWAVES * 64, 2) hymba_fwd(Args args) {
    extern __shared__ __attribute__((aligned(16))) unsigned char lds[];
    Frame F;
    F.lds = (LAS unsigned char*)lds;
    F.MISC = (volatile LAS unsigned*)(F.lds + MISC_OFF);
    F.tid = threadIdx.x; F.lane = F.tid & 63; F.wave = __builtin_amdgcn_readfirstlane(F.tid >> 6);
    F.G = gridDim.x; { const int bx = blockIdx.x; F.vcu = (F.G % 8 == 0) ? (bx % 8) * (F.G / 8) + bx / 8 : bx; }
    F.out = args.out; F.ws = args.ws; F.ctl = (gu32*)(args.ws + WS_CTL);
    for (int u = F.tid; u < (LDS_BYTES - LDSCTL_OFF) / 4; u += NWAVES * 64) ((LAS unsigned*)(F.lds + LDSCTL_OFF))[u] = 0u;
    __syncthreads();
    XcdBarrier bar = xcd_barrier_post((unsigned*)(F.ctl + CW_BAR), F.MISC + 8);
#define GRID_BAR() xcd_barrier(bar)
#ifndef REPMASK
#define REPMASK 0
#endif
#define REPS(k) (1 + (((REPMASK) >> (k)) & 1) * 2)
    bf16* XB = (bf16*)(F.ws + WS_XB);
    for (int rep = 0; rep < REPS(0); ++rep) p0_prologue(F, args);
    GRID_BAR();
    for (int rep = 0; rep < REPS(1); ++rep) {
        pg8::Gemm g{XB, (const bf16*)(F.ws + WS_WIN), MT, NIN, DM}; pg8::StaticOrder S; S.init(MT, NIN, F.G, (int)blockIdx.x);
        EpiIn E{(bf16*)(F.ws + WS_U), (bf16*)(F.ws + WS_GS), (bf16*)(F.ws + WS_V), (bf16*)(F.ws + WS_GC), (const float*)(F.ws + WS_CONST + C_BIAS), F.out + O_CV_P, F.out + O_CV_S};
        pg8::gemm_phase<EpiIn, pg8::StaticOrder, true, true>(F.lds + RING_OFF, g, S, E);
    }
    GRID_BAR();
    for (int rep = 0; rep < REPS(2); ++rep) conv_phase(F, args.in[4], args.in[17], args.in[18], args.in[19], args.in[20]);
    for (int rep = 0; rep < REPS(3); ++rep) s5_phase<0>(F, 0, 512, args.in[2], args.in[3], args.in[14]);
    GRID_BAR();
    for (int rep = 0; rep < REPS(4); ++rep) s5_carry_phase(F);
    GRID_BAR();
    for (int rep = 0; rep < REPS(5); ++rep) { s5_phase<1>(F, 0, 512, args.in[2], args.in[3], args.in[14]); s5_phase<2>(F, 512, 528, args.in[2], args.in[3], args.in[14]); }
    GRID_BAR();
    for (int rep = 0; rep < REPS(6); ++rep) {
        pg8::Gemm g{(const bf16*)(F.ws + WS_S0), (const bf16*)(F.ws + WS_W2), 2 * MT, 1024, 512}; GroupedOrder S{F.G, (int)blockIdx.x};
        EpiMix E{(const bf16*)(F.ws + WS_S0), (const bf16*)(F.ws + WS_GS), (const bf16*)(F.ws + WS_GC), (bf16*)(F.ws + WS_MIX), args.in[16], args.in[22]};
        pg8::gemm_phase<EpiMix, GroupedOrder, true, true>(F.lds + RING_OFF, g, S, E);
    }
    GRID_BAR();
    for (int rep = 0; rep < REPS(7); ++rep) {
        pg8::Gemm g{(const bf16*)(F.ws + WS_MIX), (const bf16*)(F.ws + WS_WOUT), MT, DM, DM}; pg8::StaticOrder S; S.init(MT, DM, F.G, (int)blockIdx.x);
        EpiOut E{args.in[0], args.in[1], F.out + O_Y};
        pg8::gemm_phase<EpiOut, pg8::StaticOrder, true, true>(F.lds + RING_OFF, g, S, E);
    }
    GRID_BAR();
    for (int rep = 1; rep < REPS(8); ++rep) { GRID_BAR(); }
    ln_phase(F, args.in[24], args.in[25]);
}

extern "C" void kernel_launch(void* const* d_in, const int* in_sizes, int n_in, void* d_out, int out_size, void* d_ws, size_t ws_size, hipStream_t stream) {
    static int grid = 0;
    if (grid == 0) {
        if (n_in != 26 || out_size != (int)O_END || ws_size < WS_END) { fprintf(stderr, "kernel_launch: unexpected shapes: n_in %d out %d ws %zu\n", n_in, out_size, ws_size); grid = -1; return; }
        int dev = 0, cus = 0, per_cu = 0;
        if (hipGetDevice(&dev) != hipSuccess || hipDeviceGetAttribute(&cus, hipDeviceAttributeMultiprocessorCount, dev) != hipSuccess) { grid = -1; return; }
        if (hipFuncSetAttribute((const void*)hymba_fwd, hipFuncAttributeMaxDynamicSharedMemorySize, LDS_BYTES) != hipSuccess) { fprintf(stderr, "kernel_launch: hipFuncSetAttribute failed\n"); grid = -1; return; }
        if (hipOccupancyMaxActiveBlocksPerMultiprocessor(&per_cu, (const void*)hymba_fwd, NWAVES * 64, LDS_BYTES) != hipSuccess || per_cu < 1) { fprintf(stderr, "kernel_launch: occupancy query says %d blocks per CU\n", per_cu); grid = -1; (void)hipGetLastError(); return; }
        grid = cus;
    }
    if (grid < 0) return;
    if (hipMemsetAsync((char*)d_ws + WS_CTL, 0, CTL_ZERO_BYTES, stream) != hipSuccess) return;
    Args a{};
    for (int i = 0; i < 26; ++i) a.in[i] = (const float*)d_in[i];
    a.out = (float*)d_out; a.ws = (unsigned char*)d_ws;
    void* kargs[] = {&a};
    hipError_t e = hipLaunchCooperativeKernel((const void*)hymba_fwd, dim3(grid), dim3(NWAVES * 64), kargs, LDS_BYTES, stream);
    if (e != hipSuccess) fprintf(stderr, "kernel_launch: cooperative launch failed: %s (grid %d)\n", hipGetErrorString(e), grid);
}
```

```cpp
#include <hip/hip_runtime.h>
#include <cstdio>
#include <cstdint>
namespace pg8 {
#define PG8_LAS __attribute__((address_space(3)))
typedef unsigned short bf16_t;
typedef short bf16x8 __attribute__((ext_vector_type(8)));
typedef float f32x4 __attribute__((ext_vector_type(4)));
typedef unsigned u32x4 __attribute__((ext_vector_type(4)));
constexpr int BM = 256, BK = 64, HALF = 128, HTB = HALF * BK * 2  , STAGE_BYTES = 8 * HTB, NXCD = 8, WGM = 8;

__host__ __device__ __forceinline__ int lds_byte(int r, int c) { const int st = (r >> 4) * 2 + (c >> 5), rr = r & 15, cc = c & 31, ob = rr * 64 + cc * 2; return st * 1024 + (ob ^ (((ob >> 9) & 1) << 5)); }
__host__ __device__ __forceinline__ void stage_rc(int b, int& R, int& C) { const int st = b / 1024, sb = b % 1024, swz = sb ^ (((sb >> 9) & 1) << 5); R = (st >> 1) * 16 + swz / 64; C = (st & 1) * 32 + (swz % 64) / 2; }
__host__ __device__ __forceinline__ int perm32(int rho) { const int n = rho >> 4, i = rho & 15; return 8 * (i >> 2) + 4 * n + (i & 3); }

struct Unit { int pm, pn; };
struct Gemm { const bf16_t* A; const bf16_t* Bt; int M, N, K; };

struct StaticOrder {
    int nM, nN, nwg, G, c;
    __host__ __device__ void init(int M, int N, int G_, int c_) { nM = M / BM; nN = N / BM; nwg = nM * nN; G = G_; c = c_; }
    __host__ __device__ bool next(int i, Unit& u) const {
        const long L = (long)i * G + c; if (L >= nwg) return false;
        int wgid = (int)L; { const int q = nwg / NXCD, r = nwg % NXCD, xcd = wgid % NXCD, off = wgid / NXCD; wgid = (xcd < r ? xcd * (q + 1) : r * (q + 1) + (xcd - r) * q) + off; }
        const int nig = WGM * nN, gid = wgid / nig, fm = gid * WGM, gsz = (nM - fm) < WGM ? (nM - fm) : WGM;
        u.pm = fm + ((wgid % nig) % gsz); u.pn = (wgid % nig) / gsz; return true;
    }
    __device__ __forceinline__ void a_ready(const Unit&) const {}
    __device__ __forceinline__ void done(const Unit&) const {}
};
__device__ __forceinline__ unsigned cvt_pk_bf16(float lo, float hi) { unsigned r; asm volatile("v_cvt_pk_bf16_f32 %0, %1, %2" : "=v"(r) : "v"(lo), "v"(hi)); return r; }
template <class Epi, class Sched, bool ALIGN_EPI = false, bool SP2 = false>
__device__ __forceinline__ void gemm_phase(PG8_LAS unsigned char* lds, const Gemm g, const Sched& S, const Epi& E) {
    int tid_ = threadIdx.x; asm volatile("" : "+v"(tid_));
    const int tid = tid_, wid = __builtin_amdgcn_readfirstlane(tid >> 6), lane = tid & 63, wr = wid >> 2, wc = wid & 3, fr = lane & 15, fq = lane >> 4;
    const int K = g.K, nt = K / BK;
    unsigned voffA[2], voffB[2];
#pragma unroll
    for (int i = 0; i < 2; ++i) { int R, C; stage_rc(tid * 16 + i * 8192, R, C); const int Rb = Epi::PERM ? ((R & ~31) + perm32(R & 31)) : R;
        voffA[i] = (unsigned)(R * K + C) * 2u; voffB[i] = (unsigned)(Rb * K + C) * 2u; }
    const size_t kstep = (size_t)(BK * 2);
    const size_t hstep = (size_t)HALF * K * 2;
    const size_t tstep = 2 * hstep;
    const unsigned ldsw = (unsigned)wid * 1024u;
    const int aoff = lds_byte(wr * 64 + fr, fq * 8), boff = lds_byte(wc * 32 + fr, fq * 8);
#define PG8_SA(b, h) (((b) * 2 + (h)) * HTB)
#define PG8_SB(b, h) ((4 + (b) * 2 + (h)) * HTB)
#define PG8_STAGE(bufoff, gbase, voff) do { _Pragma("unroll") for (int _i = 0; _i < 2; ++_i) \
        __builtin_amdgcn_global_load_lds((const unsigned*)((const char*)(gbase) + (voff)[_i]), (PG8_LAS unsigned*)(lds + (bufoff) + ldsw + _i * 8192), 16, 0, 0); } while (0)
#define PG8_LDA(dst, b, h) do { _Pragma("unroll") for (int m = 0; m < 4; ++m) _Pragma("unroll") for (int k = 0; k < 2; ++k) dst[m][k] = *(const PG8_LAS bf16x8*)(lds + PG8_SA(b, h) + aoff + m * 2048 + k * 1024); } while (0)
#define PG8_LDB(dst, b, h) do { _Pragma("unroll") for (int n = 0; n < 2; ++n) _Pragma("unroll") for (int k = 0; k < 2; ++k) dst[n][k] = *(const PG8_LAS bf16x8*)(lds + PG8_SB(b, h) + boff + n * 2048 + k * 1024); } while (0)
#define PG8_MMA(ai, bj, At, Bt) do { __builtin_amdgcn_s_setprio(1); _Pragma("unroll") for (int m = 0; m < 4; ++m) _Pragma("unroll") for (int n = 0; n < 2; ++n) _Pragma("unroll") for (int k = 0; k < 2; ++k) \
        acc[ai][bj][m][n] = __builtin_amdgcn_mfma_f32_16x16x32_bf16(Bt[n][k], At[m][k], acc[ai][bj][m][n], 0, 0, 0); __builtin_amdgcn_s_setprio(0); } while (0)
#define PG8_WAIT_V(n) asm volatile("s_waitcnt vmcnt(" #n ")" ::: "memory")
#define PG8_WAIT_L(n) asm volatile("s_waitcnt lgkmcnt(" #n ")" ::: "memory")
#define PG8_BAR __builtin_amdgcn_s_barrier()
#define PG8_SCHED __builtin_amdgcn_sched_barrier(0)
    Unit cur, nxt; int ui = 0;
    if (!S.next(0, cur)) return;
    f32x4 acc[2][2][4][2];
#pragma unroll
    for (int a = 0; a < 2; ++a)
#pragma unroll
        for (int b = 0; b < 2; ++b)
#pragma unroll
            for (int m = 0; m < 4; ++m)
#pragma unroll
                for (int n = 0; n < 2; ++n) acc[a][b][m][n] = (f32x4){0.f, 0.f, 0.f, 0.f};
    bf16x8 At[4][2], B0[2][2], B1[2][2];
    const char* cA = (const char*)g.A + (size_t)cur.pm * tstep; const char* cB = (const char*)g.Bt + (size_t)cur.pn * tstep;
    S.a_ready(cur);
    if constexpr (SP2) {
        PG8_STAGE(PG8_SB(0, 0), cB, voffB); PG8_STAGE(PG8_SB(0, 1), cB + hstep, voffB); PG8_STAGE(PG8_SA(0, 0), cA, voffA); PG8_STAGE(PG8_SA(0, 1), cA + hstep, voffA);
        if (wr == 1) PG8_BAR;
        PG8_WAIT_V(2); PG8_BAR;
        PG8_STAGE(PG8_SB(1, 0), cB + kstep, voffB); PG8_STAGE(PG8_SA(1, 0), cA + kstep, voffA); PG8_STAGE(PG8_SB(1, 1), cB + hstep + kstep, voffB);
        PG8_WAIT_V(6); PG8_BAR;
    } else {
        PG8_STAGE(PG8_SB(0, 0), cB, voffB); PG8_STAGE(PG8_SA(0, 0), cA, voffA); PG8_STAGE(PG8_SB(0, 1), cB + hstep, voffB); PG8_STAGE(PG8_SA(0, 1), cA + hstep, voffA);
        if (wr == 1) PG8_BAR;
        PG8_WAIT_V(4); PG8_BAR;
        PG8_STAGE(PG8_SB(1, 0), cB + kstep, voffB); PG8_STAGE(PG8_SA(1, 0), cA + kstep, voffA); PG8_STAGE(PG8_SB(1, 1), cB + hstep + kstep, voffB);
        PG8_WAIT_V(6); PG8_BAR;
    }
    for (;;) {
        const bool has_next = S.next(ui + 1, nxt);
        const char* nA = has_next ? (const char*)g.A + (size_t)nxt.pm * tstep : cA; const char* nB = has_next ? (const char*)g.Bt + (size_t)nxt.pn * tstep : cB;
        for (int t = 0; t < nt; t += 2) {
            const bool last = (t == nt - 2);
            const char* a1 = cA + (size_t)(t + 1) * kstep;
            const char* a2 = last ? nA : cA + (size_t)(t + 2) * kstep; const char* b2 = last ? nB : cB + (size_t)(t + 2) * kstep;
            const char* a3 = a2 + kstep; const char* b3 = b2 + kstep;
            if (last && has_next) S.a_ready(nxt);
            if constexpr (SP2) {
            PG8_LDB(B0, 0, 0); PG8_LDB(B1, 0, 1); PG8_SCHED; PG8_LDA(At, 0, 0); PG8_STAGE(PG8_SA(1, 1), a1 + hstep, voffA);
            PG8_WAIT_V(8); PG8_WAIT_L(0); PG8_BAR; PG8_MMA(0, 0, At, B0); PG8_MMA(0, 1, At, B1); PG8_BAR; PG8_SCHED;
            PG8_LDA(At, 0, 1); PG8_STAGE(PG8_SB(0, 0), b2, voffB); PG8_STAGE(PG8_SB(0, 1), b2 + hstep, voffB); PG8_STAGE(PG8_SA(0, 0), a2, voffA);
            PG8_WAIT_V(8); PG8_WAIT_L(0); PG8_BAR; PG8_MMA(1, 0, At, B0); PG8_MMA(1, 1, At, B1); PG8_BAR; PG8_SCHED;
            PG8_LDB(B0, 1, 0); PG8_LDB(B1, 1, 1); PG8_SCHED; PG8_LDA(At, 1, 0); PG8_STAGE(PG8_SA(0, 1), a2 + hstep, voffA);
            PG8_WAIT_V(8); PG8_WAIT_L(0); PG8_BAR; PG8_MMA(0, 0, At, B0); PG8_MMA(0, 1, At, B1); PG8_BAR; PG8_SCHED;
            PG8_LDA(At, 1, 1); PG8_STAGE(PG8_SB(1, 0), b3, voffB); PG8_STAGE(PG8_SB(1, 1), b3 + hstep, voffB); PG8_STAGE(PG8_SA(1, 0), a3, voffA);
            PG8_WAIT_V(8); PG8_WAIT_L(0); PG8_BAR; PG8_MMA(1, 0, At, B0); PG8_MMA(1, 1, At, B1); PG8_BAR; PG8_SCHED;
            } else {
            PG8_LDB(B0, 0, 0); PG8_SCHED; PG8_LDA(At, 0, 0); PG8_STAGE(PG8_SA(1, 1), a1 + hstep, voffA);
            PG8_WAIT_L(8); PG8_BAR; PG8_WAIT_L(0); PG8_MMA(0, 0, At, B0); PG8_BAR; PG8_SCHED;
            PG8_LDB(B1, 0, 1); PG8_STAGE(PG8_SB(0, 0), b2, voffB);
            PG8_BAR; PG8_WAIT_L(0); PG8_MMA(0, 1, At, B1); PG8_BAR;
            PG8_LDA(At, 0, 1); PG8_STAGE(PG8_SA(0, 0), a2, voffA);
            PG8_BAR; PG8_WAIT_L(0); PG8_MMA(1, 0, At, B0); PG8_BAR; PG8_SCHED;
            PG8_STAGE(PG8_SB(0, 1), b2 + hstep, voffB);
            PG8_WAIT_V(6); PG8_BAR; PG8_MMA(1, 1, At, B1); PG8_BAR;
            PG8_LDB(B0, 1, 0); PG8_SCHED; PG8_LDA(At, 1, 0); PG8_STAGE(PG8_SA(0, 1), a2 + hstep, voffA);
            PG8_WAIT_L(8); PG8_BAR; PG8_WAIT_L(0); PG8_MMA(0, 0, At, B0); PG8_BAR; PG8_SCHED;
            PG8_LDB(B1, 1, 1); PG8_STAGE(PG8_SB(1, 0), b3, voffB);
            PG8_BAR; PG8_WAIT_L(0); PG8_MMA(0, 1, At, B1); PG8_BAR;
            PG8_LDA(At, 1, 1); PG8_STAGE(PG8_SA(1, 0), a3, voffA);
            PG8_BAR; PG8_WAIT_L(0); PG8_MMA(1, 0, At, B0); PG8_BAR; PG8_SCHED;
            PG8_STAGE(PG8_SB(1, 1), b3 + hstep, voffB);
            PG8_WAIT_V(6); PG8_BAR; PG8_MMA(1, 1, At, B1); PG8_BAR;
            }
        }
        if constexpr (ALIGN_EPI) { if (wr == 0) PG8_BAR; }
        if constexpr (!Epi::AFTER_DRAIN) { E(acc, cur, wr, wc, fr, fq); S.done(cur); }
        if (!has_next) break;
#pragma unroll
        for (int a = 0; a < 2; ++a)
#pragma unroll
            for (int b = 0; b < 2; ++b)
#pragma unroll
                for (int m = 0; m < 4; ++m)
#pragma unroll
                    for (int n = 0; n < 2; ++n) acc[a][b][m][n] = (f32x4){0.f, 0.f, 0.f, 0.f};
        cur = nxt; cA = nA; cB = nB; ++ui;
        if constexpr (ALIGN_EPI) { if (wr == 1) PG8_BAR; }
    }
    PG8_WAIT_V(0);
    if constexpr (!ALIGN_EPI) { if (wr == 0) PG8_BAR; }
    PG8_BAR;
    if constexpr (Epi::AFTER_DRAIN) { E.fused(acc, cur, wr, wc, fr, fq, lds, wid, lane); S.done(cur); }
#undef PG8_SA
#undef PG8_SB
#undef PG8_STAGE
#undef PG8_LDA
#undef PG8_LDB
#undef PG8_MMA
#undef PG8_WAIT_V
#undef PG8_WAIT_L
#undef PG8_BAR
#undef PG8_SCHED
}
}
#define GAS __attribute__((address_space(1)))
#define LAS __attribute__((address_space(3)))
typedef unsigned short bf16;
typedef unsigned v4u __attribute__((ext_vector_type(4)));
typedef float f32x4 __attribute__((ext_vector_type(4)));
typedef short bf16x8 __attribute__((ext_vector_type(8)));
typedef GAS unsigned gu32;
typedef GAS unsigned long long gu64;
#define RLX_AGENT __ATOMIC_RELAXED, __HIP_MEMORY_SCOPE_AGENT
#define LDS_WAIT() asm volatile("s_waitcnt lgkmcnt(0)" ::: "memory")
#define VM_WAIT() asm volatile("s_waitcnt vmcnt(0)" ::: "memory")
__device__ __forceinline__ unsigned long long rt() { return __builtin_amdgcn_s_memrealtime(); }
__device__ __forceinline__ unsigned f2bf(float f) { unsigned u = __builtin_bit_cast(unsigned, f); return (u + 0x7fffu + ((u >> 16) & 1u)) >> 16; }
__device__ __forceinline__ unsigned pk2(float lo, float hi) { return f2bf(lo) | (f2bf(hi) << 16); }
#define XB_TMO      128
#define XB_XCNT(j)  (256  + 64 * (j))
#define XB_XSUB(j)  (1280 + 64 * (j))
#define XB_XGEN(j)  (2304 + 64 * (j))
#define XB_TOP      3328
#define XB_TOPGEN   3392
#define XCD_BAR_WORDS 3456
#define XB_SPIN_CAP (1u << 18)

__device__ __forceinline__ unsigned xb_ld(unsigned* p)              { return __hip_atomic_load(p, __ATOMIC_RELAXED, __HIP_MEMORY_SCOPE_AGENT); }
__device__ __forceinline__ unsigned xb_add(unsigned* p, unsigned v) { return __hip_atomic_fetch_add(p, v, __ATOMIC_RELAXED, __HIP_MEMORY_SCOPE_AGENT); }
__device__ __forceinline__ unsigned xb_xcc_id() { return (unsigned)__builtin_amdgcn_s_getreg((3 << 11) | 20) & 0xFu; }
#define XB_SPIN(cond, bar) do { unsigned _sp = 0; while (cond) { __builtin_amdgcn_s_sleep(1); \
    if ((++_sp & 255u) == 0u) { if (xb_ld(&(bar)[XB_TMO])) break; if (_sp > XB_SPIN_CAP) { atomicAdd(&(bar)[XB_TMO], 1u); break; } } } } while (0)

struct XcdBarrier {
    unsigned* bar; unsigned x;
    volatile LAS unsigned* st;
};

__device__ __forceinline__ XcdBarrier xcd_barrier_post(unsigned* bar, volatile LAS unsigned* st) {
    XcdBarrier b; b.bar = bar; b.x = xb_xcc_id(); b.st = st;
    if (threadIdx.x == 0) (void)xb_add(&bar[XB_XCNT(b.x)], 1u);
    return b;
}
__device__ __forceinline__ void xcd_barrier_complete(unsigned* bar, unsigned x, unsigned& nloc, unsigned& nx) {
    const unsigned G = gridDim.x * gridDim.y * gridDim.z;
    unsigned sum, cnt, mine, sp = 0u;
    for (;;) {
        sum = 0u; cnt = 0u; mine = 0u;
#pragma unroll
        for (unsigned j = 0; j < 16; ++j) { const unsigned c = xb_ld(&bar[XB_XCNT(j)]); sum += c; cnt += (c > 0u) ? 1u : 0u; mine = (j == x) ? c : mine; }
        if (sum == G) break;
        __builtin_amdgcn_s_sleep(1);
        if ((++sp & 255u) == 0u) { if (xb_ld(&bar[XB_TMO])) break; if (sp > XB_SPIN_CAP) { atomicAdd(&bar[XB_TMO], 1u); break; } }
    }
    nloc = mine > 0u ? mine : 1u; nx = cnt > 0u ? cnt : 1u;
}

__device__ __forceinline__ void xcd_barrier(const XcdBarrier& b) {
    asm volatile("s_waitcnt vmcnt(0)" ::: "memory");
    __syncthreads();
    if (threadIdx.x == 0) {
        unsigned* bar = b.bar;
        __builtin_amdgcn_s_waitcnt(0);
        unsigned nloc = b.st[0], nx = b.st[1];
        if (nloc == 0u) { xcd_barrier_complete(bar, b.x, nloc, nx); b.st[0] = nloc; b.st[1] = nx; }
        const unsigned old = xb_add(&bar[XB_XSUB(b.x)], 1u);
        const unsigned gen = old / nloc;
        if (old + 1u == (gen + 1u) * nloc) {
            __builtin_amdgcn_fence(__ATOMIC_RELEASE, "agent");
            asm volatile("s_waitcnt vmcnt(0)" ::: "memory");
            const unsigned og = xb_add(&bar[XB_TOP], 1u);
            const unsigned tg = og / nx;
            if (og + 1u == (tg + 1u) * nx) xb_add(&bar[XB_TOPGEN], 1u);
            else XB_SPIN(xb_ld(&bar[XB_TOPGEN]) == tg, bar);
            __builtin_amdgcn_fence(__ATOMIC_ACQUIRE, "agent");
            xb_add(&bar[XB_XGEN(b.x)], 1u);
            asm volatile("s_waitcnt vmcnt(0)" ::: "memory");
        } else {
            XB_SPIN(xb_ld(&bar[XB_XGEN(b.x)]) == gen, bar);
            __builtin_amdgcn_fence(__ATOMIC_ACQUIRE, "agent");
            asm volatile("s_waitcnt vmcnt(0)" ::: "memory");
        }
    }
    __syncthreads();
}
constexpr int NWAVES = 8, NT = 512;
constexpr int DM = 1024, MP = 16384, MSMP = 512, MT = MP + MSMP;
constexpr int NIN = 2560;
constexpr float LN_EPS = 1e-5f, ALPHA = 1.189207115002721f;
constexpr size_t MiB = 1u << 20;
constexpr size_t WS_CTL = 0, CTL_ZERO_BYTES = 1 * MiB;
constexpr size_t WS_WIN = 2 * MiB;
constexpr size_t WS_W2 = 7 * MiB;
constexpr size_t WS_WOUT = 8 * MiB;
constexpr size_t WS_CONST = 10 * MiB;
constexpr size_t WS_XB = 12 * MiB;
constexpr size_t WS_U = 46 * MiB, WS_GS = 63 * MiB, WS_V = 80 * MiB, WS_GC = 97 * MiB;
constexpr size_t WS_S0 = 114 * MiB;
constexpr size_t WS_CN = WS_S0 + (size_t)MT * 512 * 2;
constexpr size_t WS_MIX = 148 * MiB;
constexpr size_t WS_E = 182 * MiB, WS_HS = 198 * MiB;
constexpr size_t WS_END = 214 * MiB;
constexpr size_t C_LAM1 = 0, C_LAM16 = 16384, C_LAM256 = 32768, C_BIAS = 49152, C_BFRAG = 65536, C_CFRAG = 65536 + 131072;
constexpr size_t O_Y = 0, O_RE_P = 17301504, O_IM_P = 17317888, O_CV_P = 17334272, O_RE_S = 17457152, O_IM_S = 17719296, O_CV_S = 17981440, O_END = 19947520;
constexpr int CW_TMO = 0, CW_BAR = 4096;
constexpr int RING_OFF = 0, RING_BYTES = 131072, LDSCTL_OFF = RING_BYTES, MISC_OFF = LDSCTL_OFF + 320, STATS_OFF = RING_BYTES + 1024, LDS_BYTES = 147456;
typedef float f32x16 __attribute__((ext_vector_type(16)));
typedef float f32x2 __attribute__((ext_vector_type(2)));
typedef short s16x4 __attribute__((ext_vector_type(4)));
typedef unsigned v2u __attribute__((ext_vector_type(2)));
typedef __bf16 bf16x2_t __attribute__((ext_vector_type(2)));
__device__ __forceinline__ unsigned pkbf(float a, float b) { f32x2 v = {a, b}; return __builtin_bit_cast(unsigned, __builtin_convertvector(v, bf16x2_t)); }
__device__ __forceinline__ float bflo(unsigned w) { return __builtin_bit_cast(float, w << 16); }
__device__ __forceinline__ float bfhi(unsigned w) { return __builtin_bit_cast(float, w & 0xffff0000u); }
__device__ __forceinline__ float bf1(bf16 v) { return __builtin_bit_cast(float, (unsigned)v << 16); }
__device__ __forceinline__ float sigm(float x) { return __builtin_amdgcn_rcpf(1.0f + __builtin_amdgcn_exp2f(-1.4426950408889634f * x)); }
__device__ __forceinline__ float siluf(float x) { return x * sigm(x); }
__device__ __forceinline__ float gelu_tanh(float x) { const float z = 0.7978845608028654f * (x + 0.044715f * x * x * x); return x * sigm(2.0f * z); }
__device__ __forceinline__ float wave_sum(float v) {
#pragma unroll
    for (int o = 1; o < 64; o <<= 1) v += __shfl_xor(v, o);
    return v;
}
#define MFMA32(a, b, c) __builtin_amdgcn_mfma_f32_32x32x16_bf16((a), (b), (c), 0, 0, 0)

struct Args { const float* in[26]; float* out; unsigned char* ws; };
struct Frame {
    LAS unsigned char* lds;
    volatile LAS unsigned* MISC;
    gu32* ctl;
    int tid, lane, wave, vcu, G;
    float* out;
    unsigned char* ws;
};

__device__ __forceinline__ int win_perm(int c) {
    if (c < 1024 || c >= 2048) return c;
    if (c < 1536) { const int q = (c - 1024) >> 7, i = (c - 1024) & 127; return 1024 + 256 * q + i; }
    const int q = (c - 1536) >> 7, i = (c - 1536) & 127; return 1024 + 256 * q + 128 + i;
}

__device__ __forceinline__ void p0_transpose_item(const float* W, int K, int N, bf16* WT, int k0, int n0, int dst_row0, LAS float* scr, int lane) {
#pragma unroll 8
    for (int i = 0; i < 32; ++i) { const int kk = 2 * i + (lane >> 5); scr[kk * 33 + (lane & 31)] = W[(size_t)(k0 + kk) * N + n0 + (lane & 31)]; }
    LDS_WAIT(); asm volatile("" ::: "memory");
    const int c = lane & 7;
#pragma unroll
    for (int j = 0; j < 4; ++j) { const int n = (lane >> 3) + 8 * j; const LAS float* s = scr + (8 * c) * 33 + n;
        v4u o; o.x = pkbf(s[0 * 33], s[1 * 33]); o.y = pkbf(s[2 * 33], s[3 * 33]); o.z = pkbf(s[4 * 33], s[5 * 33]); o.w = pkbf(s[6 * 33], s[7 * 33]);
        *(v4u*)(WT + (size_t)(dst_row0 + n) * K + k0 + 8 * c) = o; }
    LDS_WAIT(); asm volatile("" ::: "memory");
}
__device__ __forceinline__ void s5_coef(const float* lam_re, const float* lam_im, const float* log_dt, int g, int n, double& lbr, double& lbi, double& cr, double& ci) {
    const double dt = exp((double)log_dt[g]);
    const double lr = (double)lam_re[g * 64 + n], li = (double)lam_im[g * 64 + n];
    const double mag = exp(lr * dt), ang = li * dt;
    lbr = mag * cos(ang); lbi = mag * sin(ang);
    const double ar = lbr - 1.0, ai = lbi, den = lr * lr + li * li;
    cr = (ar * lr + ai * li) / den; ci = (ai * lr - ar * li) / den;
}
__device__ __forceinline__ void p0_prologue(Frame& F, const Args& A) {
    LAS float* scr = (LAS float*)(F.lds + RING_OFF + F.wave * 16384);
    const int gw = F.vcu * NWAVES + F.wave, NGW = F.G * NWAVES;
    bf16* WinT = (bf16*)(F.ws + WS_WIN); bf16* W2T = (bf16*)(F.ws + WS_W2); bf16* WoutT = (bf16*)(F.ws + WS_WOUT);
    for (int it = gw; it < 2048; it += NGW) {
        int r = it;
        if (r < 1280) { const int kb = r / 80, nb = r % 80; p0_transpose_item(A.in[5], 1024, NIN, WinT, 64 * kb, 32 * nb, win_perm(32 * nb), scr, F.lane); continue; } r -= 1280;
        if (r < 128) { const int kb = r / 16, nb = r % 16; p0_transpose_item(A.in[15], 512, 512, W2T, 64 * kb, 32 * nb, 32 * nb, scr, F.lane); continue; } r -= 128;
        if (r < 128) { const int kb = r / 16, nb = r % 16; p0_transpose_item(A.in[21], 512, 512, W2T, 64 * kb, 32 * nb, 512 + 32 * nb, scr, F.lane); continue; } r -= 128;
        { const int kb = r / 32, nb = r % 32; p0_transpose_item(A.in[23], 1024, 1024, WoutT, 64 * kb, 32 * nb, 32 * nb, scr, F.lane); }
    }
    bf16* XB = (bf16*)(F.ws + WS_XB);
    for (int m = gw; m < MT; m += NGW) {
        const float* xrow = m < MP ? A.in[0] + (size_t)m * DM : A.in[1] + (size_t)(m - MP) * DM;
        const f32x4* xr = (const f32x4*)xrow + F.lane; v2u* o8 = (v2u*)(XB + (size_t)m * DM) + F.lane;
#pragma unroll
        for (int j = 0; j < 4; ++j) { const f32x4 v = xr[64 * j]; v2u o; o.x = pkbf(v.x, v.y); o.y = pkbf(v.z, v.w); o8[64 * j] = o; }
    }
    const int gt = F.vcu * NT + F.tid, GT = F.G * NT;
    unsigned char* cb = F.ws + WS_CONST;
    const float *lam_re = A.in[7], *lam_im = A.in[8], *log_dt = A.in[9], *b_re = A.in[10], *b_im = A.in[11], *c_re = A.in[12], *c_im = A.in[13];
    for (int idx = gt; idx < 2048; idx += GT) {
        const int g = idx >> 6, n = idx & 63; double lr, li, cr, ci; s5_coef(lam_re, lam_im, log_dt, g, n, lr, li, cr, ci);
        ((f32x2*)(cb + C_LAM1))[idx] = (f32x2){(float)lr, (float)li};
        double pr = lr, pi = li;
#pragma unroll 1
        for (int k = 0; k < 4; ++k) { const double t = pr * pr - pi * pi; pi = 2.0 * pr * pi; pr = t; }
        ((f32x2*)(cb + C_LAM16))[idx] = (f32x2){(float)pr, (float)pi};
#pragma unroll 1
        for (int k = 0; k < 4; ++k) { const double t = pr * pr - pi * pi; pi = 2.0 * pr * pi; pr = t; }
        ((f32x2*)(cb + C_LAM256))[idx] = (f32x2){(float)pr, (float)pi};
    }
    for (int idx = gt; idx < 8192; idx += GT) {
        const int lane = idx & 63, ct = (idx >> 6) & 3, g = idx >> 8, r = lane & 31, h = lane >> 5, st = 32 * (ct >> 1) + r;
        double lr, li, cr, ci; s5_coef(lam_re, lam_im, log_dt, g, st, lr, li, cr, ci);
        float v[8];
#pragma unroll
        for (int j = 0; j < 8; ++j) { const int p = 8 * h + j; const double br = (double)b_re[(g * 64 + st) * 16 + p], bi = (double)b_im[(g * 64 + st) * 16 + p];
            v[j] = (ct & 1) ? (float)(cr * bi + ci * br) : (float)(cr * br - ci * bi); }
        v4u o; o.x = pkbf(v[0], v[1]); o.y = pkbf(v[2], v[3]); o.z = pkbf(v[4], v[5]); o.w = pkbf(v[6], v[7]);
        ((v4u*)(cb + C_BFRAG))[idx] = o;
    }
    for (int idx = gt; idx < 16384; idx += GT) {
        const int lane = idx & 63, s = (idx >> 6) & 1, ct = (idx >> 7) & 3, g = idx >> 9, r = lane & 31, h = lane >> 5;
        float v[8];
#pragma unroll
        for (int j = 0; j < 8; ++j) { const int st = 32 * (ct >> 1) + 16 * s + 8 * h + j;
            v[j] = r < 16 ? ((ct & 1) ? -c_im[(g * 16 + r) * 64 + st] : c_re[(g * 16 + r) * 64 + st]) : 0.f; }
        v4u o; o.x = pkbf(v[0], v[1]); o.y = pkbf(v[2], v[3]); o.z = pkbf(v[4], v[5]); o.w = pkbf(v[6], v[7]);
        ((v4u*)(cb + C_CFRAG))[idx] = o;
    }
    for (int idx = gt; idx < NIN; idx += GT) ((float*)(cb + C_BIAS))[win_perm(idx)] = A.in[6][idx];
    { const f32x4* src = (const f32x4*)A.in[4]; f32x4* dst = (f32x4*)(F.out + O_CV_S);
      for (int idx = gt; idx < 128 * 3328; idx += GT) { const int s = idx / 3328, v = idx % 3328; dst[s * 3840 + v] = src[s * 3840 + 512 + v]; } }
}
struct EpiIn {
    static constexpr bool PERM = true, AFTER_DRAIN = false;
    bf16 *U, *GS, *V, *GC; const float* biasp; float *convp, *convs;
    __device__ __forceinline__ void operator()(const f32x4 (&acc)[2][2][4][2], const pg8::Unit& u, int wr, int wc, int fr, int fq) const {
        const int row0 = u.pm * 256 + wr * 64 + fr, pn = u.pn, cl = wc * 32 + 8 * fq;
        if (pn >= 4 && pn < 8) {
            const int q = pn - 4;
            const f32x4 ba0 = *(const f32x4*)(biasp + 1024 + 256 * q + cl), ba1 = *(const f32x4*)(biasp + 1024 + 256 * q + cl + 4);
            const f32x4 bb0 = *(const f32x4*)(biasp + 1024 + 256 * q + 128 + cl), bb1 = *(const f32x4*)(biasp + 1024 + 256 * q + 128 + cl + 4);
#pragma unroll
            for (int ai = 0; ai < 2; ++ai)
#pragma unroll
                for (int m = 0; m < 4; ++m) {
                    const int row = row0 + ai * 128 + m * 16;
                    const f32x4 a0 = acc[ai][0][m][0] + ba0, a1 = acc[ai][0][m][1] + ba1, b0 = acc[ai][1][m][0] + bb0, b1 = acc[ai][1][m][1] + bb1;
                    f32x4 v0, v1;
#pragma unroll
                    for (int e = 0; e < 4; ++e) { v0[e] = a0[e] * sigm(b0[e]); v1[e] = a1[e] * sigm(b1[e]); }
                    v4u w; w.x = pkbf(v0[0], v0[1]); w.y = pkbf(v0[2], v0[3]); w.z = pkbf(v1[0], v1[1]); w.w = pkbf(v1[2], v1[3]);
                    *(v4u*)(V + (size_t)row * 512 + 128 * q + cl) = w;
                    float* cd = nullptr;
                    if (row < MP) { const int t = row & 2047; if (t >= 2018) cd = convp + ((size_t)(row >> 11) * 30 + (t - 2018)) * 512 + 128 * q + cl; }
                    else { const int s = (row - MP) >> 2, j = row & 3; cd = convs + ((size_t)s * 30 + 26 + j) * 512 + 128 * q + cl; }
                    if (cd) { *(f32x4*)cd = v0; *(f32x4*)(cd + 4) = v1; }
                }
        } else {
            bf16* dst; int cofs; bool act;
            if (pn < 2) { dst = U; cofs = pn * 256; act = false; } else if (pn < 4) { dst = GS; cofs = (pn - 2) * 256; act = true; } else { dst = GC; cofs = (pn - 8) * 256; act = true; }
#pragma unroll
            for (int bj = 0; bj < 2; ++bj) {
                const f32x4 bv0 = *(const f32x4*)(biasp + pn * 256 + bj * 128 + cl), bv1 = *(const f32x4*)(biasp + pn * 256 + bj * 128 + cl + 4);
#pragma unroll
                for (int ai = 0; ai < 2; ++ai)
#pragma unroll
                    for (int m = 0; m < 4; ++m) {
                        const int row = row0 + ai * 128 + m * 16;
                        f32x4 v0 = acc[ai][bj][m][0] + bv0, v1 = acc[ai][bj][m][1] + bv1;
                        if (act) {
#pragma unroll
                            for (int e = 0; e < 4; ++e) { v0[e] = siluf(v0[e]); v1[e] = siluf(v1[e]); } }
                        v4u w; w.x = pkbf(v0[0], v0[1]); w.y = pkbf(v0[2], v0[3]); w.z = pkbf(v1[0], v1[1]); w.w = pkbf(v1[2], v1[3]);
                        *(v4u*)(dst + (size_t)row * 512 + cofs + bj * 128 + cl) = w;
                    }
            }
        }
    }
};
struct GroupedOrder {
    int G, c;
    __device__ __forceinline__ bool next(int i, pg8::Unit& u) const { const int L = i * G + c; if (L >= 264) return false; const int grp = L / 132, rem = L % 132; u.pm = grp * 66 + (rem >> 1); u.pn = grp * 2 + (rem & 1); return true; }
    __device__ __forceinline__ void a_ready(const pg8::Unit&) const {}
    __device__ __forceinline__ void done(const pg8::Unit&) const {}
};
struct EpiMix {
    static constexpr bool PERM = true, AFTER_DRAIN = false;
    const bf16 *S0, *GS, *GC; bf16* MIX; const float *b_glu, *b_pw2;
    __device__ __forceinline__ void operator()(const f32x4 (&acc)[2][2][4][2], const pg8::Unit& u, int wr, int wc, int fr, int fq) const {
        const int grp = u.pn >> 1, row0 = (u.pm - 66 * grp) * 256 + wr * 64 + fr, cl = wc * 32 + 8 * fq;
        const float* bias = grp ? b_pw2 : b_glu;
#pragma unroll
        for (int bj = 0; bj < 2; ++bj) {
            const int col = (u.pn & 1) * 256 + bj * 128 + cl;
            const f32x4 bv0 = *(const f32x4*)(bias + col), bv1 = *(const f32x4*)(bias + col + 4);
#pragma unroll
            for (int ai = 0; ai < 2; ++ai)
#pragma unroll
                for (int m = 0; m < 4; ++m) {
                    const int row = row0 + ai * 128 + m * 16;
                    const f32x4 v0 = acc[ai][bj][m][0] + bv0, v1 = acc[ai][bj][m][1] + bv1;
                    float r[8];
                    if (grp == 0) {
                        const v4u s = *(const v4u*)(S0 + (size_t)row * 512 + col), g = *(const v4u*)(GS + (size_t)row * 512 + col);
                        r[0] = sigm(v0[0]) * bflo(s.x) * bflo(g.x); r[1] = sigm(v0[1]) * bfhi(s.x) * bfhi(g.x); r[2] = sigm(v0[2]) * bflo(s.y) * bflo(g.y); r[3] = sigm(v0[3]) * bfhi(s.y) * bfhi(g.y);
                        r[4] = sigm(v1[0]) * bflo(s.z) * bflo(g.z); r[5] = sigm(v1[1]) * bfhi(s.z) * bfhi(g.z); r[6] = sigm(v1[2]) * bflo(s.w) * bflo(g.w); r[7] = sigm(v1[3]) * bfhi(s.w) * bfhi(g.w);
                    } else {
                        const v4u g = *(const v4u*)(GC + (size_t)row * 512 + col);
                        r[0] = v0[0] * bflo(g.x); r[1] = v0[1] * bfhi(g.x); r[2] = v0[2] * bflo(g.y); r[3] = v0[3] * bfhi(g.y);
                        r[4] = v1[0] * bflo(g.z); r[5] = v1[1] * bfhi(g.z); r[6] = v1[2] * bflo(g.w); r[7] = v1[3] * bfhi(g.w);
                    }
                    v4u w; w.x = pkbf(r[0], r[1]); w.y = pkbf(r[2], r[3]); w.z = pkbf(r[4], r[5]); w.w = pkbf(r[6], r[7]);
                    *(v4u*)(MIX + (size_t)row * 1024 + grp * 512 + col) = w;
                }
        }
    }
};
struct EpiOut {
    static constexpr bool PERM = false, AFTER_DRAIN = false;
    const float *xp, *xs; float* Y;
    __device__ __forceinline__ void operator()(const f32x4 (&acc)[2][2][4][2], const pg8::Unit& u, int wr, int wc, int fr, int fq) const {
        const int row0 = u.pm * 256 + wr * 64 + fr, col0 = u.pn * 256 + wc * 32 + 4 * fq;
#pragma unroll
        for (int ai = 0; ai < 2; ++ai)
#pragma unroll
            for (int m = 0; m < 4; ++m) {
                const int row = row0 + ai * 128 + m * 16;
                const float* xr = row < MP ? xp + (size_t)row * DM : xs + (size_t)(row - MP) * DM;
#pragma unroll
                for (int bj = 0; bj < 2; ++bj)
#pragma unroll
                    for (int n = 0; n < 2; ++n) { const int col = col0 + bj * 128 + n * 16; const f32x4 xv = *(const f32x4*)(xr + col);
                        *(f32x4*)(Y + (size_t)row * DM + col) = xv * ALPHA + acc[ai][bj][m][n]; }
            }
    }
};
template <int MODE>
__device__ __forceinline__ void s5_unit(const Frame& F, int tile32, int g, LAS unsigned char* img, const float* ssm_re, const float* ssm_im, const float* d_skip) {
    const int lane = F.lane, r = lane & 31, h = lane >> 5;
    const bf16* U = (const bf16*)(F.ws + WS_U);
    const unsigned char* cb = F.ws + WS_CONST;
    const int rowbase = tile32 * 32;
    const int tokA = 16 * ((r >> 2) & 1) + (r & 3) + 4 * (r >> 3);
    const bf16x8 au = *(const bf16x8*)(U + (size_t)(rowbase + tokA) * 512 + 16 * g + 8 * h);
    f32x16 acc[4];
    const f32x16 zero16 = {0.f, 0.f, 0.f, 0.f, 0.f, 0.f, 0.f, 0.f, 0.f, 0.f, 0.f, 0.f, 0.f, 0.f, 0.f, 0.f};
#pragma unroll
    for (int ct = 0; ct < 4; ++ct) { const bf16x8 bfr = ((const bf16x8*)(cb + C_BFRAG))[(g * 4 + ct) * 64 + lane]; acc[ct] = MFMA32(au, bfr, zero16); }
#pragma unroll
    for (int sh = 0; sh < 2; ++sh) {
        const int n = 32 * sh + r;
        const f32x2 lam = ((const f32x2*)(cb + C_LAM1))[g * 64 + n];
        float hr = 0.f, hi = 0.f;
        if (MODE == 1) { const f32x2 hs = ((const f32x2*)(F.ws + WS_HS))[((size_t)(2 * tile32 + h) * 32 + g) * 64 + n]; hr = hs.x; hi = hs.y; }
#pragma unroll
        for (int i = 0; i < 16; ++i) {
            if (MODE == 2 && (i & 3) == 0) { const int seq = (tile32 - 512) * 8 + 4 * h + (i >> 2); hr = ssm_re[(seq * 32 + g) * 64 + n]; hi = ssm_im[(seq * 32 + g) * 64 + n]; }
            const float nr = lam.x * hr - lam.y * hi + acc[2 * sh][i], ni = lam.x * hi + lam.y * hr + acc[2 * sh + 1][i];
            hr = nr; hi = ni; acc[2 * sh][i] = hr; acc[2 * sh + 1][i] = hi;
            if (MODE == 2 && (i & 3) == 3) { const int seq = (tile32 - 512) * 8 + 4 * h + (i >> 2); F.out[O_RE_S + (seq * 32 + g) * 64 + n] = hr; F.out[O_IM_S + (seq * 32 + g) * 64 + n] = hi; }
        }
        if (MODE == 0) ((f32x2*)(F.ws + WS_E))[((size_t)(2 * tile32 + h) * 32 + g) * 64 + n] = (f32x2){hr, hi};
    }
    if (MODE == 0) return;
#pragma unroll
    for (int ct = 0; ct < 4; ++ct) {
        v4u w0, w1;
        w0.x = pkbf(acc[ct][0], acc[ct][1]); w0.y = pkbf(acc[ct][2], acc[ct][3]); w0.z = pkbf(acc[ct][4], acc[ct][5]); w0.w = pkbf(acc[ct][6], acc[ct][7]);
        w1.x = pkbf(acc[ct][8], acc[ct][9]); w1.y = pkbf(acc[ct][10], acc[ct][11]); w1.z = pkbf(acc[ct][12], acc[ct][13]); w1.w = pkbf(acc[ct][14], acc[ct][15]);
        LAS v4u* p = (LAS v4u*)(img + (ct * 32 + r) * 64 + 32 * h);
        p[0] = w0; p[1] = w1;
    }
    const int i16 = lane & 15, q = i16 >> 2, p4 = i16 & 3, blk = (lane >> 4) & 1;
    const unsigned taddr = (unsigned)(uintptr_t)img + (unsigned)((8 * h + q) * 64 + 8 * (4 * blk + p4));
    f32x16 y = zero16;
#pragma unroll
    for (int ct = 0; ct < 4; ++ct) {
        s16x4 lo0, hi0, lo1, hi1;
        asm volatile("s_waitcnt lgkmcnt(0)\n\tds_read_b64_tr_b16 %0, %4 offset:%5\n\tds_read_b64_tr_b16 %1, %4 offset:%6\n\tds_read_b64_tr_b16 %2, %4 offset:%7\n\tds_read_b64_tr_b16 %3, %4 offset:%8\n\ts_waitcnt lgkmcnt(0)"
                     : "=&v"(lo0), "=&v"(hi0), "=&v"(lo1), "=&v"(hi1) : "v"(taddr), "i"(ct * 2048), "i"(ct * 2048 + 256), "i"(ct * 2048 + 1024), "i"(ct * 2048 + 1280) : "memory");
        const bf16x8 h0 = __builtin_shufflevector(lo0, hi0, 0, 1, 2, 3, 4, 5, 6, 7), h1 = __builtin_shufflevector(lo1, hi1, 0, 1, 2, 3, 4, 5, 6, 7);
        const bf16x8 c0 = ((const bf16x8*)(cb + C_CFRAG))[((g * 4 + ct) * 2 + 0) * 64 + lane], c1 = ((const bf16x8*)(cb + C_CFRAG))[((g * 4 + ct) * 2 + 1) * 64 + lane];
        y = MFMA32(c0, h0, y); y = MFMA32(c1, h1, y);
    }
    const int row = rowbase + r;
    bf16* S0 = (bf16*)(F.ws + WS_S0);
#pragma unroll
    for (int hf = 0; hf < 2; ++hf) {
        const int p0 = 8 * hf + 4 * h, ch = 16 * g + p0;
        const v2u uu = *(const v2u*)(U + (size_t)row * 512 + ch);
        const f32x4 dk = *(const f32x4*)(d_skip + ch);
        const float y0 = gelu_tanh(y[4 * hf + 0] + dk[0] * bflo(uu.x)), y1 = gelu_tanh(y[4 * hf + 1] + dk[1] * bfhi(uu.x));
        const float y2 = gelu_tanh(y[4 * hf + 2] + dk[2] * bflo(uu.y)), y3 = gelu_tanh(y[4 * hf + 3] + dk[3] * bfhi(uu.y));
        v2u o; o.x = pkbf(y0, y1); o.y = pkbf(y2, y3);
        *(v2u*)(S0 + (size_t)row * 512 + ch) = o;
    }
}
template <int MODE>
__device__ __forceinline__ void s5_phase(const Frame& F, int tile_lo, int tile_hi, const float* ssm_re, const float* ssm_im, const float* d_skip) {
    LAS unsigned char* img = F.lds + RING_OFF + F.wave * 8192;
    const int gw = F.vcu * NWAVES + F.wave, NGW = F.G * NWAVES, nun = (tile_hi - tile_lo) * 32;
    for (int un = gw; un < nun; un += NGW) s5_unit<MODE>(F, tile_lo + (un >> 5), un & 31, img, ssm_re, ssm_im, d_skip);
}
__device__ __forceinline__ void s5_carry_phase(const Frame& F) {
    const unsigned char* cb = F.ws + WS_CONST;
    LAS f32x2* seg = (LAS f32x2*)(F.lds + RING_OFF);
    const int n = F.lane, w = F.wave;
    for (int un = F.vcu; un < 256; un += F.G) {
        const int b = un >> 5, g = un & 31;
        const f32x2 l16 = ((const f32x2*)(cb + C_LAM16))[g * 64 + n], l256 = ((const f32x2*)(cb + C_LAM256))[g * 64 + n];
        const f32x2* E = (const f32x2*)(F.ws + WS_E) + ((size_t)(b * 128 + 16 * w) * 32 + g) * 64 + n;
        f32x2* HS = (f32x2*)(F.ws + WS_HS) + ((size_t)(b * 128 + 16 * w) * 32 + g) * 64 + n;
        float pr[16], pi[16];
#pragma unroll
        for (int j = 0; j < 16; ++j) { const f32x2 e = E[(size_t)j * 2048]; pr[j] = e.x; pi[j] = e.y; }
#pragma unroll
        for (int j = 1; j < 16; ++j) { const float tr = l16.x * pr[j - 1] - l16.y * pi[j - 1] + pr[j], ti = l16.x * pi[j - 1] + l16.y * pr[j - 1] + pi[j]; pr[j] = tr; pi[j] = ti; }
        seg[w * 64 + n] = (f32x2){pr[15], pi[15]};
        __syncthreads();
        float cr = 0.f, ci = 0.f;
        for (int k = 0; k < w; ++k) { const f32x2 t = seg[k * 64 + n]; const float tr = l256.x * cr - l256.y * ci + t.x, ti = l256.x * ci + l256.y * cr + t.y; cr = tr; ci = ti; }
#pragma unroll
        for (int j = 0; j < 16; ++j) {
            f32x2 hs; hs.x = cr + (j ? pr[j - 1] : 0.f); hs.y = ci + (j ? pi[j - 1] : 0.f);
            HS[(size_t)j * 2048] = hs;
            const float tr = l16.x * cr - l16.y * ci, ti = l16.x * ci + l16.y * cr; cr = tr; ci = ti;
        }
        if (w == 7) { F.out[O_RE_P + (b * 32 + g) * 64 + n] = cr + pr[15]; F.out[O_IM_P + (b * 32 + g) * 64 + n] = ci + pi[15]; }
        __syncthreads();
    }
}
__device__ __forceinline__ void conv_ln_store(const Frame& F, LAS float* tile, LAS f32x2* stats, int ntok, int rowbase, int ch, float gl, float bl, bf16* CN) {
    __syncthreads();
    for (int t = F.wave; t < ntok; t += NWAVES) {
        const f32x4 a = *(const LAS f32x4*)(tile + t * 512 + 4 * F.lane), c = *(const LAS f32x4*)(tile + t * 512 + 256 + 4 * F.lane);
        const float mean = wave_sum((a.x + a.y) + (a.z + a.w) + (c.x + c.y) + (c.z + c.w)) * (1.0f / 512.0f);
        const f32x4 da = a - mean, dc = c - mean;
        const float var = wave_sum((da.x * da.x + da.y * da.y) + (da.z * da.z + da.w * da.w) + (dc.x * dc.x + dc.y * dc.y) + (dc.z * dc.z + dc.w * dc.w)) * (1.0f / 512.0f);
        if (F.lane == 0) stats[t] = (f32x2){mean, 1.0f / sqrtf(var + LN_EPS)};
    }
    __syncthreads();
#pragma unroll 4
    for (int t = 0; t < ntok; ++t) { const f32x2 st = stats[t]; const float yv = (tile[t * 512 + ch] - st.x) * st.y * gl + bl; CN[(size_t)(rowbase + t) * 512 + ch] = (bf16)(pkbf(siluf(yv), 0.f) & 0xffffu); }
    __syncthreads();
}
template <int S, int K> struct ConvFma {
    static __device__ __forceinline__ void run(float (&acc)[31], const float (&w)[31], float x, float bdw) {
        constexpr int j = S - K;
        if constexpr (j >= 0 && j < 64) { if constexpr (K == 0) acc[j % 31] = bdw + w[0] * x; else acc[j % 31] += w[K] * x; }
        if constexpr (K + 1 < 31) ConvFma<S, K + 1>::run(acc, w, x, bdw);
    }
};
template <int S0, int N, int I> struct ConvChunk {
    static __device__ __forceinline__ void run(float (&acc)[31], const float (&w)[31], const unsigned short (&xc)[16], float bdw, bool first, LAS float* tile, int ch) {
        constexpr int S = S0 + I;
        float x = __builtin_bit_cast(float, (unsigned)xc[I] << 16);
        if constexpr (S < 30) x = first ? 0.f : x;
        ConvFma<S, 0>::run(acc, w, x, bdw);
        if constexpr (S >= 30) tile[(S - 30) * 512 + ch] = acc[(S - 30) % 31];
        if constexpr (I + 1 < N) ConvChunk<S0, N, I + 1>::run(acc, w, xc, bdw, first, tile, ch);
    }
};
template <int S0, int N> __device__ __forceinline__ void conv_load(unsigned short (&xc)[16], const bf16* Vu, int ch) {
#pragma unroll
    for (int i = 0; i < N; ++i) xc[i] = Vu[(S0 + i) * 512 + ch];
}
__device__ __forceinline__ void conv_phase(const Frame& F, const float* state_conv, const float* w_dw, const float* b_dw, const float* g_ln, const float* b_ln) {
    const int ch = F.tid;
    const bf16* V = (const bf16*)(F.ws + WS_V); bf16* CN = (bf16*)(F.ws + WS_CN);
    LAS float* tile = (LAS float*)(F.lds + RING_OFF);
    LAS f32x2* stats = (LAS f32x2*)(F.lds + STATS_OFF);
    float w[31];
#pragma unroll
    for (int k = 0; k < 31; ++k) w[k] = w_dw[k * 512 + ch];
    const float bdw = b_dw[ch], gl = g_ln[ch], bl = b_ln[ch];
    for (int ut = F.vcu; ut < 256; ut += F.G) {
        const int b = ut >> 5, t0 = (ut & 31) * 64, rowbase = b * 2048 + t0;
        const bool first = (t0 == 0);
        const bf16* Vu = V + (size_t)(rowbase - 30) * 512;
        float acc[31];
        unsigned short xa[16], xb[16];
        conv_load<0, 16>(xa, Vu, ch); __builtin_amdgcn_sched_barrier(0);
        conv_load<16, 16>(xb, Vu, ch); __builtin_amdgcn_sched_barrier(0); ConvChunk<0, 16, 0>::run(acc, w, xa, bdw, first, tile, ch);
        conv_load<32, 16>(xa, Vu, ch); __builtin_amdgcn_sched_barrier(0); ConvChunk<16, 16, 0>::run(acc, w, xb, bdw, first, tile, ch);
        conv_load<48, 16>(xb, Vu, ch); __builtin_amdgcn_sched_barrier(0); ConvChunk<32, 16, 0>::run(acc, w, xa, bdw, first, tile, ch);
        conv_load<64, 16>(xa, Vu, ch); __builtin_amdgcn_sched_barrier(0); ConvChunk<48, 16, 0>::run(acc, w, xb, bdw, first, tile, ch);
        conv_load<80, 14>(xb, Vu, ch); __builtin_amdgcn_sched_barrier(0); ConvChunk<64, 16, 0>::run(acc, w, xa, bdw, first, tile, ch);
        ConvChunk<80, 14, 0>::run(acc, w, xb, bdw, first, tile, ch);
        conv_ln_store(F, tile, stats, 64, rowbase, ch, gl, bl, CN);
    }
    for (int sq = F.vcu; sq < 128; sq += F.G) {
        float ve[34];
#pragma unroll
        for (int i = 0; i < 30; ++i) ve[i] = state_conv[((size_t)sq * 30 + i) * 512 + ch];
#pragma unroll
        for (int i = 0; i < 4; ++i) ve[30 + i] = bf1(V[(size_t)(MP + 4 * sq + i) * 512 + ch]);
#pragma unroll
        for (int j = 0; j < 4; ++j) { float a = bdw;
#pragma unroll
            for (int k = 0; k < 31; ++k) a += w[k] * ve[j + k];
            tile[j * 512 + ch] = a; }
        conv_ln_store(F, tile, stats, 4, MP + 4 * sq, ch, gl, bl, CN);
    }
}
__device__ __forceinline__ void ln_phase(const Frame& F, const float* g_post, const float* b_post) {
    const int gw = F.vcu * NWAVES + F.wave, NGW = F.G * NWAVES;
    for (int m = gw; m < MT; m += NGW) {
        f32x4* xr = (f32x4*)(F.out + O_Y + (size_t)m * DM) + F.lane;
        f32x4 v[4]; float s = 0.f;
#pragma unroll
        for (int j = 0; j < 4; ++j) { v[j] = xr[64 * j]; s += (v[j].x + v[j].y) + (v[j].z + v[j].w); }
        const float mean = wave_sum(s) * (1.f / DM); float s2 = 0.f;
#pragma unroll
        for (int j = 0; j < 4; ++j) { v[j] = v[j] - mean; s2 += (v[j].x * v[j].x + v[j].y * v[j].y) + (v[j].z * v[j].z + v[j].w * v[j].w); }
        const float rstd = 1.f / sqrtf(wave_sum(s2) * (1.f / DM) + LN_EPS);
#pragma unroll
        for (int j = 0; j < 4; ++j) { const f32x4 gp = ((const f32x4*)g_post)[64 * j + F.lane], bp = ((const f32x4*)b_post)[64 * j + F.lane]; xr[64 * j] = v[j] * rstd * gp + bp; }
    }
}
__global__ void __launch_bounds__(NWAVES * 64, 2) hymba_fwd(Args args) {
    extern __shared__ __attribute__((aligned(16))) unsigned char lds[];
    Frame F;
    F.lds = (LAS unsigned char*)lds;
    F.MISC = (volatile LAS unsigned*)(F.lds + MISC_OFF);
    F.tid = threadIdx.x; F.lane = F.tid & 63; F.wave = __builtin_amdgcn_readfirstlane(F.tid >> 6);
    F.G = gridDim.x; { const int bx = blockIdx.x; F.vcu = (F.G % 8 == 0) ? (bx % 8) * (F.G / 8) + bx / 8 : bx; }
    F.out = args.out; F.ws = args.ws; F.ctl = (gu32*)(args.ws + WS_CTL);
    for (int u = F.tid; u < (LDS_BYTES - LDSCTL_OFF) / 4; u += NWAVES * 64) ((LAS unsigned*)(F.lds + LDSCTL_OFF))[u] = 0u;
    __syncthreads();
    XcdBarrier bar = xcd_barrier_post((unsigned*)(F.ctl + CW_BAR), F.MISC + 8);
#define GRID_BAR() xcd_barrier(bar)
#ifndef REPMASK
#define REPMASK 0
#endif
#define REPS(k) (1 + (((REPMASK) >> (k)) & 1) * 2)
    bf16* XB = (bf16*)(F.ws + WS_XB);
    for (int rep = 0; rep < REPS(0); ++rep) p0_prologue(F, args);
    GRID_BAR();
    for (int rep = 0; rep < REPS(1); ++rep) {
        pg8::Gemm g{XB, (const bf16*)(F.ws + WS_WIN), MT, NIN, DM}; pg8::StaticOrder S; S.init(MT, NIN, F.G, (int)blockIdx.x);
        EpiIn E{(bf16*)(F.ws + WS_U), (bf16*)(F.ws + WS_GS), (bf16*)(F.ws + WS_V), (bf16*)(F.ws + WS_GC), (const float*)(F.ws + WS_CONST + C_BIAS), F.out + O_CV_P, F.out + O_CV_S};
        pg8::gemm_phase<EpiIn, pg8::StaticOrder, true, true>(F.lds + RING_OFF, g, S, E);
    }
    GRID_BAR();
    for (int rep = 0; rep < REPS(2); ++rep) conv_phase(F, args.in[4], args.in[17], args.in[18], args.in[19], args.in[20]);
    for (int rep = 0; rep < REPS(3); ++rep) s5_phase<0>(F, 0, 512, args.in[2], args.in[3], args.in[14]);
    GRID_BAR();
    for (int rep = 0; rep < REPS(4); ++rep) s5_carry_phase(F);
    GRID_BAR();
    for (int rep = 0; rep < REPS(5); ++rep) { s5_phase<1>(F, 0, 512, args.in[2], args.in[3], args.in[14]); s5_phase<2>(F, 512, 528, args.in[2], args.in[3], args.in[14]); }
    GRID_BAR();
    for (int rep = 0; rep < REPS(6); ++rep) {
        pg8::Gemm g{(const bf16*)(F.ws + WS_S0), (const bf16*)(F.ws + WS_W2), 2 * MT, 1024, 512}; GroupedOrder S{F.G, (int)blockIdx.x};
        EpiMix E{(const bf16*)(F.ws + WS_S0), (const bf16*)(F.ws + WS_GS), (const bf16*)(F.ws + WS_GC), (bf16*)(F.ws + WS_MIX), args.in[16], args.in[22]};
        pg8::gemm_phase<EpiMix, GroupedOrder, true, true>(F.lds + RING_OFF, g, S, E);
    }
    GRID_BAR();
    for (int rep = 0; rep < REPS(7); ++rep) {
        pg8::Gemm g{(const bf16*)(F.ws + WS_MIX), (const bf16*)(F.ws + WS_WOUT), MT, DM, DM}; pg8::StaticOrder S; S.init(MT, DM, F.G, (int)blockIdx.x);
        EpiOut E{args.in[0], args.in[1], F.out + O_Y};
        pg8::gemm_phase<EpiOut, pg8::StaticOrder, true, true>(F.lds + RING_OFF, g, S, E);
    }
    GRID_BAR();
    for (int rep = 1; rep < REPS(8); ++rep) { GRID_BAR(); }
    ln_phase(F, args.in[24], args.in[25]);
}

extern "C" void kernel_launch(void* const* d_in, const int* in_sizes, int n_in, void* d_out, int out_size, void* d_ws, size_t ws_size, hipStream_t stream) {
    static int grid = 0;
    if (grid == 0) {
        if (n_in != 26 || out_size != (int)O_END || ws_size < WS_END) { fprintf(stderr, "kernel_launch: unexpected shapes: n_in %d out %d ws %zu\n", n_in, out_size, ws_size); grid = -1; return; }
        int dev = 0, cus = 0, per_cu = 0;
        if (hipGetDevice(&dev) != hipSuccess || hipDeviceGetAttribute(&cus, hipDeviceAttributeMultiprocessorCount, dev) != hipSuccess) { grid = -1; return; }
        if (hipFuncSetAttribute((const void*)hymba_fwd, hipFuncAttributeMaxDynamicSharedMemorySize, LDS_BYTES) != hipSuccess) { fprintf(stderr, "kernel_launch: hipFuncSetAttribute failed\n"); grid = -1; return; }
        if (hipOccupancyMaxActiveBlocksPerMultiprocessor(&per_cu, (const void*)hymba_fwd, NWAVES * 64, LDS_BYTES) != hipSuccess || per_cu < 1) { fprintf(stderr, "kernel_launch: occupancy query says %d blocks per CU\n", per_cu); grid = -1; (void)hipGetLastError(); return; }
        grid = cus;
    }
    if (grid < 0) return;
    if (hipMemsetAsync((char*)d_ws + WS_CTL, 0, CTL_ZERO_BYTES, stream) != hipSuccess) return;
    Args a{};
    for (int i = 0; i < 26; ++i) a.in[i] = (const float*)d_in[i];
    a.out = (float*)d_out; a.ws = (unsigned char*)d_ws;
    void* kargs[] = {&a};
    hipError_t e = hipLaunchCooperativeKernel((const void*)hymba_fwd, dim3(grid), dim3(NWAVES * 64), kargs, LDS_BYTES, stream);
    if (e != hipSuccess) fprintf(stderr, "kernel_launch: cooperative launch failed: %s (grid %d)\n", hipGetErrorString(e), grid);
}
```
